# Optimizing an MI355X kernel written in HIP

```python
import jax, jax.numpy as jnp
from jax import lax
import numpy as np

D_MODEL = 1024
BATCH = 8
SEQ = 2048
DEPTH = 4

GRID_W = 64
CTX_LEN = 256
N_MIXERS = 2
N_HEADS = 16
N_KV_HEADS = 4
HEAD_DIM = D_MODEL // N_HEADS
GROUP = N_HEADS // N_KV_HEADS
Q_DIM = N_HEADS * HEAD_DIM
KV_DIM = N_KV_HEADS * HEAD_DIM
WINDOW = 128
BLOCK = 128
ROPE_THETA = 10000.0
ROPE_QUARTER = HEAD_DIM // 4
CONV_WIDTH = 3
D_FF = 2816
N_MOD = 9
RMS_EPS = 1e-6
NEG_INF = -1e30
HALF_STEP = 0.5

kernel_name = 'hybrid_shortconv_swa_macaron_dit'


def rmsnorm(x, g):
    xf = x.astype(jnp.float32)
    y = xf * lax.rsqrt(jnp.mean(xf * xf, axis=-1, keepdims=True) + RMS_EPS)
    return (y * g.astype(jnp.float32)).astype(x.dtype)


def adaln_in(x, g, shift, scale):
    return rmsnorm(x, g) * (1 + scale) + shift


def adaln_out(x, y, g, gate, weight):
    return x + weight * gate * rmsnorm(y, g)


def swiglu(h, w_gu, w_down):
    gu = h @ w_gu
    return (jax.nn.silu(gu[..., :D_FF]) * gu[..., D_FF:]) @ w_down


def ffn_sublayer(x, mod, k, g_pre, g_post, w_gu, w_down):
    h = adaln_in(x, g_pre, mod[k], mod[k + 1])
    return adaln_out(x, swiglu(h, w_gu, w_down), g_post, mod[k + 2], HALF_STEP)


def short_conv_mixer(h, w_in, w_conv, w_out):
    bcu = h @ w_in
    b, cg, u = bcu[..., :D_MODEL], bcu[..., D_MODEL:2 * D_MODEL], bcu[..., 2 * D_MODEL:]
    up = jnp.pad(cg * u, ((0, 0), (1, 1), (0, 0)))
    y = w_conv[0] * up[:, :-2] + w_conv[1] * up[:, 1:-1] + w_conv[2] * up[:, 2:]
    return (b * y) @ w_out


def axial_rope_tables(n_tokens, dtype):
    rows = n_tokens // GRID_W
    row = jnp.broadcast_to(jnp.arange(rows)[:, None], (rows, GRID_W)).reshape(-1).astype(jnp.float32)
    col = jnp.broadcast_to(jnp.arange(GRID_W)[None, :], (rows, GRID_W)).reshape(-1).astype(jnp.float32)
    inv_freq = ROPE_THETA ** (-jnp.arange(ROPE_QUARTER, dtype=jnp.float32) / ROPE_QUARTER)
    ang = jnp.stack([row[:, None] * inv_freq, col[:, None] * inv_freq], axis=1)
    return jnp.cos(ang)[:, None].astype(dtype), jnp.sin(ang)[:, None].astype(dtype)


def apply_rope(t, cos, sin):
    t4 = t.reshape(t.shape[:-1] + (2, 2, ROPE_QUARTER))
    x1, x2 = t4[..., 0, :], t4[..., 1, :]
    out = jnp.stack([x1 * cos - x2 * sin, x2 * cos + x1 * sin], axis=-2)
    return out.reshape(t.shape)


def banded_blocks(t, nb):
    B = t.shape[0]
    tp = jnp.pad(t, ((0, 0), (BLOCK, BLOCK), (0, 0), (0, 0)))
    tp = tp.reshape(B, nb + 2, BLOCK, N_KV_HEADS, HEAD_DIM)
    return jnp.concatenate([tp[:, :-2], tp[:, 1:-1], tp[:, 2:]], axis=2)


def band_mask(nb, n_tokens):
    a = jnp.arange(BLOCK)[:, None]
    b = jnp.arange(3 * BLOCK)[None, :]
    off = b - a
    in_win = (off >= BLOCK - WINDOW) & (off <= BLOCK + WINDOW)
    key_pos = (jnp.arange(nb)[:, None] - 1) * BLOCK + b
    valid = (key_pos >= 0) & (key_pos < n_tokens)
    return in_win[None] & valid[:, None, :]


def window_attention_mixer(hx, hz, w_qkv, w_o, sink, cos, sin, ctx_queries):
    B, S, _ = hx.shape
    C = hz.shape[1]
    nb = S // BLOCK
    nk = 3 * BLOCK
    scale = HEAD_DIM ** -0.5
    qkv = hx @ w_qkv
    q = apply_rope(qkv[..., :Q_DIM].reshape(B, S, N_HEADS, HEAD_DIM), cos, sin) * scale
    k = apply_rope(qkv[..., Q_DIM:Q_DIM + KV_DIM].reshape(B, S, N_KV_HEADS, HEAD_DIM), cos, sin)
    v = qkv[..., Q_DIM + KV_DIM:].reshape(B, S, N_KV_HEADS, HEAD_DIM)
    kvz = hz @ w_qkv[:, Q_DIM:]
    kz = kvz[..., :KV_DIM].reshape(B, C, N_KV_HEADS, HEAD_DIM)
    vz = kvz[..., KV_DIM:].reshape(B, C, N_KV_HEADS, HEAD_DIM)
    sink_l = sink.reshape(N_KV_HEADS, GROUP).astype(jnp.float32)

    qb = q.reshape(B, nb, BLOCK, N_KV_HEADS, GROUP, HEAD_DIM)
    kb = banded_blocks(k, nb)
    vb = banded_blocks(v, nb)
    s_win = jnp.einsum('bnqhgd,bnkhd->bnhgqk', qb, kb).astype(jnp.float32)
    s_win = jnp.where(band_mask(nb, S)[None, :, None, None], s_win, NEG_INF)
    s_ctx = jnp.einsum('bnqhgd,bchd->bnhgqc', qb, kz).astype(jnp.float32)
    s_sink = jnp.broadcast_to(sink_l[None, None, :, :, None, None], s_win.shape[:-1] + (1,))
    p = jax.nn.softmax(jnp.concatenate([s_win, s_ctx, s_sink], axis=-1), axis=-1).astype(v.dtype)
    o = (jnp.einsum('bnhgqk,bnkhd->bnqhgd', p[..., :nk], vb)
         + jnp.einsum('bnhgqc,bchd->bnqhgd', p[..., nk:nk + C], vz))
    yx = o.reshape(B, S, Q_DIM) @ w_o

    yz = None
    if ctx_queries:
        qz = (hz @ w_qkv[:, :Q_DIM]).reshape(B, C, N_KV_HEADS, GROUP, HEAD_DIM) * scale
        sz = jnp.einsum('bqhgd,bkhd->bhgqk', qz, kz).astype(jnp.float32)
        sz_sink = jnp.broadcast_to(sink_l[None, :, :, None, None], sz.shape[:-1] + (1,))
        pz = jax.nn.softmax(jnp.concatenate([sz, sz_sink], axis=-1), axis=-1).astype(vz.dtype)
        oz = jnp.einsum('bhgqk,bkhd->bqhgd', pz[..., :C], vz)
        yz = oz.reshape(B, C, Q_DIM) @ w_o
    return yx, yz


def setup_inputs(seed: int = 0) -> dict:
    key = jax.random.key(seed)
    ks = jax.random.split(key, 16)
    n_conv = (DEPTH + 1) // N_MIXERS
    n_attn = DEPTH // N_MIXERS

    def w(k, shape, fan_in, gain=1.0):
        return gain * fan_in ** -0.5 * jax.random.normal(k, shape, jnp.float32)

    return {
        'x': jax.random.normal(ks[0], (BATCH, SEQ, D_MODEL), jnp.float32),
        'c': jax.random.normal(ks[1], (BATCH, D_MODEL), jnp.float32),
        'ctx': jax.random.normal(ks[2], (BATCH, CTX_LEN, D_MODEL), jnp.float32),
        'c_ctx': jax.random.normal(ks[3], (D_MODEL,), jnp.float32),
        'w_mod': w(ks[4], (DEPTH, D_MODEL, N_MOD * D_MODEL), D_MODEL, 0.5),
        'b_mod': 0.02 * jax.random.normal(ks[5], (DEPTH, N_MOD * D_MODEL), jnp.float32),
        'norm_g': 1.0 + 0.05 * jax.random.normal(ks[6], (DEPTH, 6, D_MODEL), jnp.float32),
        'ffn_w_gu': w(ks[7], (DEPTH, 2, D_MODEL, 2 * D_FF), D_MODEL),
        'ffn_w_down': w(ks[8], (DEPTH, 2, D_FF, D_MODEL), D_FF),
        'conv_w_in': w(ks[9], (n_conv, D_MODEL, 3 * D_MODEL), D_MODEL),
        'conv_w': w(ks[10], (n_conv, CONV_WIDTH, D_MODEL), CONV_WIDTH),
        'conv_w_out': w(ks[11], (n_conv, D_MODEL, D_MODEL), D_MODEL),
        'attn_w_qkv': w(ks[12], (n_attn, D_MODEL, Q_DIM + 2 * KV_DIM), D_MODEL),
        'attn_w_o': w(ks[13], (n_attn, Q_DIM, D_MODEL), Q_DIM),
        'attn_sink': 0.5 * jax.random.normal(ks[14], (n_attn, N_HEADS), jnp.float32),
    }


def reference(x, c, ctx, c_ctx, w_mod, b_mod, norm_g, ffn_w_gu, ffn_w_down,
              conv_w_in, conv_w, conv_w_out, attn_w_qkv, attn_w_o, attn_sink):
    B, S, D = x.shape
    cos, sin = axial_rope_tables(S, x.dtype)
    z = ctx
    for i in range(DEPTH):
        last = i == DEPTH - 1
        use_attn = (i % N_MIXERS) == 1
        j = i // N_MIXERS
        g = norm_g[i]
        mx = (jax.nn.silu(c) @ w_mod[i] + b_mod[i]).reshape(B, N_MOD, 1, D).transpose(1, 0, 2, 3)
        mz = (jax.nn.silu(c_ctx) @ w_mod[i] + b_mod[i]).reshape(N_MOD, D)
        ctx_needed = (not last) or use_attn

        x = ffn_sublayer(x, mx, 0, g[0], g[1], ffn_w_gu[i, 0], ffn_w_down[i, 0])
        if ctx_needed:
            z = ffn_sublayer(z, mz, 0, g[0], g[1], ffn_w_gu[i, 0], ffn_w_down[i, 0])

        hx = adaln_in(x, g[2], mx[3], mx[4])
        if use_attn:
            hz = adaln_in(z, g[2], mz[3], mz[4])
            yx, yz = window_attention_mixer(hx, hz, attn_w_qkv[j], attn_w_o[j], attn_sink[j],
                                            cos, sin, not last)
        else:
            yx = short_conv_mixer(hx, conv_w_in[j], conv_w[j], conv_w_out[j])
            yz = None
            if not last:
                hz = adaln_in(z, g[2], mz[3], mz[4])
                yz = short_conv_mixer(hz, conv_w_in[j], conv_w[j], conv_w_out[j])
        x = adaln_out(x, yx, g[3], mx[5], 1.0)

        x = ffn_sublayer(x, mx, 6, g[4], g[5], ffn_w_gu[i, 1], ffn_w_down[i, 1])
        if not last:
            z = adaln_out(z, yz, g[3], mz[5], 1.0)
            z = ffn_sublayer(z, mz, 6, g[4], g[5], ffn_w_gu[i, 1], ffn_w_down[i, 1])
    return x
```

```cpp
#include <hip/hip_runtime.h>
#include <hip/hip_cooperative_groups.h>
#include <cstdio>
#include <cstdint>
namespace cg = cooperative_groups;
namespace pg8 {
#define PG8_LAS __attribute__((address_space(3)))
typedef unsigned short bf16_t;
typedef short bf16x8 __attribute__((ext_vector_type(8)));
typedef float f32x4 __attribute__((ext_vector_type(4)));
typedef unsigned u32x4 __attribute__((ext_vector_type(4)));
constexpr int BM = 256, BK = 64, HALF = 128, HTB = HALF * BK * 2  , STAGE_BYTES = 8 * HTB, NXCD = 8, WGM = 8;

__host__ __device__ __forceinline__ int lds_byte(int r, int c) { const int st = (r >> 4) * 2 + (c >> 5), rr = r & 15, cc = c & 31, ob = rr * 64 + cc * 2; return st * 1024 + (ob ^ (((ob >> 9) & 1) << 5)); }
__host__ __device__ __forceinline__ void stage_rc(int b, int& R, int& C) { const int st = b / 1024, sb = b % 1024, swz = sb ^ (((sb >> 9) & 1) << 5); R = (st >> 1) * 16 + swz / 64; C = (st & 1) * 32 + (swz % 64) / 2; }
__host__ __device__ __forceinline__ int perm32(int rho) { const int n = rho >> 4, i = rho & 15; return 8 * (i >> 2) + 4 * n + (i & 3); }

struct Unit { int pm, pn; };
struct Gemm { const bf16_t* A; const bf16_t* Bt; int M, N, K; };

struct StaticOrder {
    int nM, nN, nwg, G, c;
    __host__ __device__ void init(int M, int N, int G_, int c_) { nM = M / BM; nN = N / BM; nwg = nM * nN; G = G_; c = c_; }
    __host__ __device__ bool next(int i, Unit& u) const {
        const long L = (long)i * G + c; if (L >= nwg) return false;
        int wgid = (int)L; { const int q = nwg / NXCD, r = nwg % NXCD, xcd = wgid % NXCD, off = wgid / NXCD; wgid = (xcd < r ? xcd * (q + 1) : r * (q + 1) + (xcd - r) * q) + off; }
        const int nig = WGM * nN, gid = wgid / nig, fm = gid * WGM, gsz = (nM - fm) < WGM ? (nM - fm) : WGM;
        u.pm = fm + ((wgid % nig) % gsz); u.pn = (wgid % nig) / gsz; return true;
    }
    __device__ __forceinline__ void a_ready(const Unit&) const {}
    __device__ __forceinline__ void done(const Unit&) const {}
};

__device__ __forceinline__ unsigned cvt_pk_bf16(float lo, float hi) { unsigned r; asm volatile("v_cvt_pk_bf16_f32 %0, %1, %2" : "=v"(r) : "v"(lo), "v"(hi)); return r; }
typedef float f32x2 __attribute__((ext_vector_type(2)));
__device__ __forceinline__ f32x2 gelu_pk(f32x2 v) {
    const f32x2 av = __builtin_elementwise_abs(v), d = av * 0.2316418882f + 1.0f;
    f32x2 t; t.x = __builtin_amdgcn_rcpf(d.x); t.y = __builtin_amdgcn_rcpf(d.y);
    f32x2 q = t * 0.5307027145f + (-0.7265760135f); q = q * t + 0.7107068705f; q = q * t + (-0.142248368f); q = q * t + 0.127414796f; q = q * t;
    const f32x2 s = (v * v) * (-0.72134752044f);
    f32x2 e; e.x = __builtin_amdgcn_exp2f(s.x); e.y = __builtin_amdgcn_exp2f(s.y);
    const f32x2 m = v * (q * e), r = v - m;
    f32x2 o; o.x = v.x < 0.f ? m.x : r.x; o.y = v.y < 0.f ? m.y : r.y; return o;
}

template <int ACT  > struct EpiBf16 {
    static constexpr bool PERM = true, AFTER_DRAIN = false; static_assert(ACT == 0 || ACT == 1, "EpiBf16: ACT is 0 (none) or 1 (gelu_pk)");
    bf16_t* O; int ldc; const float* bias; int split_cols; size_t split_stride; float scale0;
    __device__ __forceinline__ void operator()(const f32x4 (&acc)[2][2][4][2], const Unit& u, int wr, int wc, int fr, int fq) const {
        const int row0 = u.pm * BM + wr * 64 + fr; int colt = u.pn * BM; bf16_t* base = O;
        float sc = 1.f; if (split_cols) { const int t = colt / split_cols; base += (size_t)t * split_stride; colt -= t * split_cols; if (t == 0) sc = scale0; }
        const int col0 = colt + wc * 32 + 8 * fq, bcol0 = u.pn * BM + wc * 32 + 8 * fq;
        f32x4 bv[2][2];
#pragma unroll
        for (int bj = 0; bj < 2; ++bj)
#pragma unroll
            for (int n = 0; n < 2; ++n) bv[bj][n] = bias ? *(const f32x4*)(bias + bcol0 + bj * HALF + 4 * n) : (f32x4){0.f, 0.f, 0.f, 0.f};
#pragma unroll
        for (int ai = 0; ai < 2; ++ai)
#pragma unroll
            for (int m = 0; m < 4; ++m) { bf16_t* rowp = base + (size_t)(row0 + ai * HALF + m * 16) * ldc + col0;
#pragma unroll
                for (int bj = 0; bj < 2; ++bj) { f32x4 v0 = acc[ai][bj][m][0] + bv[bj][0], v1 = acc[ai][bj][m][1] + bv[bj][1];
                    if (ACT == 1) { f32x2 a = gelu_pk((f32x2){v0[0], v0[1]}), b = gelu_pk((f32x2){v0[2], v0[3]}), c = gelu_pk((f32x2){v1[0], v1[1]}), d = gelu_pk((f32x2){v1[2], v1[3]});
                        v0 = (f32x4){a.x, a.y, b.x, b.y}; v1 = (f32x4){c.x, c.y, d.x, d.y}; }
                    v0 = v0 * sc; v1 = v1 * sc; u32x4 w; w.x = cvt_pk_bf16(v0[0], v0[1]); w.y = cvt_pk_bf16(v0[2], v0[3]); w.z = cvt_pk_bf16(v1[0], v1[1]); w.w = cvt_pk_bf16(v1[2], v1[3]);
                    *(u32x4*)(rowp + bj * HALF) = w; } }
    }
};
template <class Epi, class Sched, bool ALIGN_EPI = false, bool SP2 = false>
__device__ __forceinline__ void gemm_phase(PG8_LAS unsigned char* lds, const Gemm g, const Sched& S, const Epi& E) {
    const int tid = threadIdx.x, wid = __builtin_amdgcn_readfirstlane(tid >> 6), lane = tid & 63, wr = wid >> 2, wc = wid & 3, fr = lane & 15, fq = lane >> 4;
    const int K = g.K, nt = K / BK;
    unsigned voffA[2], voffB[2];
#pragma unroll
    for (int i = 0; i < 2; ++i) { int R, C; stage_rc(tid * 16 + i * 8192, R, C); const int Rb = E.perm ? ((R & ~31) + perm32(R & 31)) : R;
        voffA[i] = (unsigned)(R * K + C) * 2u; voffB[i] = (unsigned)(Rb * K + C) * 2u; }
    const size_t kstep = (size_t)(BK * 2);
    const size_t hstep = (size_t)HALF * K * 2;
    const size_t tstep = 2 * hstep;
    const unsigned ldsw = (unsigned)wid * 1024u;
    const int aoff = lds_byte(wr * 64 + fr, fq * 8), boff = lds_byte(wc * 32 + fr, fq * 8);
#define PG8_SA(b, h) (((b) * 2 + (h)) * HTB)
#define PG8_SB(b, h) ((4 + (b) * 2 + (h)) * HTB)
#define PG8_STAGE(bufoff, gbase, voff) do { _Pragma("unroll") for (int _i = 0; _i < 2; ++_i) \
        __builtin_amdgcn_global_load_lds((const unsigned*)((const char*)(gbase) + (voff)[_i]), (PG8_LAS unsigned*)(lds + (bufoff) + ldsw + _i * 8192), 16, 0, 0); } while (0)
#define PG8_LDA(dst, b, h) do { _Pragma("unroll") for (int m = 0; m < 4; ++m) _Pragma("unroll") for (int k = 0; k < 2; ++k) dst[m][k] = *(const PG8_LAS bf16x8*)(lds + PG8_SA(b, h) + aoff + m * 2048 + k * 1024); } while (0)
#define PG8_LDB(dst, b, h) do { _Pragma("unroll") for (int n = 0; n < 2; ++n) _Pragma("unroll") for (int k = 0; k < 2; ++k) dst[n][k] = *(const PG8_LAS bf16x8*)(lds + PG8_SB(b, h) + boff + n * 2048 + k * 1024); } while (0)
#define PG8_MMA(ai, bj, At, Bt) do { __builtin_amdgcn_s_setprio(1); _Pragma("unroll") for (int m = 0; m < 4; ++m) _Pragma("unroll") for (int n = 0; n < 2; ++n) _Pragma("unroll") for (int k = 0; k < 2; ++k) \
        acc[ai][bj][m][n] = __builtin_amdgcn_mfma_f32_16x16x32_bf16(Bt[n][k], At[m][k], acc[ai][bj][m][n], 0, 0, 0); __builtin_amdgcn_s_setprio(0); } while (0)
#define PG8_WAIT_V(n) asm volatile("s_waitcnt vmcnt(" #n ")" ::: "memory")
#define PG8_WAIT_L(n) asm volatile("s_waitcnt lgkmcnt(" #n ")" ::: "memory")
#define PG8_BAR __builtin_amdgcn_s_barrier()
#define PG8_SCHED __builtin_amdgcn_sched_barrier(0)
    Unit cur, nxt; int ui = 0;
    if (!S.next(0, cur)) return;
    f32x4 acc[2][2][4][2];
#pragma unroll
    for (int a = 0; a < 2; ++a)
#pragma unroll
        for (int b = 0; b < 2; ++b)
#pragma unroll
            for (int m = 0; m < 4; ++m)
#pragma unroll
                for (int n = 0; n < 2; ++n) acc[a][b][m][n] = (f32x4){0.f, 0.f, 0.f, 0.f};
    bf16x8 At[4][2], B0[2][2], B1[2][2];
    const char* cA = (const char*)g.A + (size_t)cur.pm * tstep; const char* cB = (const char*)g.Bt + (size_t)cur.pn * tstep;
    S.a_ready(cur);
    if constexpr (SP2) {
        PG8_STAGE(PG8_SB(0, 0), cB, voffB); PG8_STAGE(PG8_SB(0, 1), cB + hstep, voffB); PG8_STAGE(PG8_SA(0, 0), cA, voffA); PG8_STAGE(PG8_SA(0, 1), cA + hstep, voffA);
        if (wr == 1) PG8_BAR;
        PG8_WAIT_V(2); PG8_BAR;
        PG8_STAGE(PG8_SB(1, 0), cB + kstep, voffB); PG8_STAGE(PG8_SA(1, 0), cA + kstep, voffA); PG8_STAGE(PG8_SB(1, 1), cB + hstep + kstep, voffB);
        PG8_WAIT_V(6); PG8_BAR;
    } else {
        PG8_STAGE(PG8_SB(0, 0), cB, voffB); PG8_STAGE(PG8_SA(0, 0), cA, voffA); PG8_STAGE(PG8_SB(0, 1), cB + hstep, voffB); PG8_STAGE(PG8_SA(0, 1), cA + hstep, voffA);
        if (wr == 1) PG8_BAR;
        PG8_WAIT_V(4); PG8_BAR;
        PG8_STAGE(PG8_SB(1, 0), cB + kstep, voffB); PG8_STAGE(PG8_SA(1, 0), cA + kstep, voffA); PG8_STAGE(PG8_SB(1, 1), cB + hstep + kstep, voffB);
        PG8_WAIT_V(6); PG8_BAR;
    }
    for (;;) {
        const bool has_next = S.next(ui + 1, nxt);
        const char* nA = has_next ? (const char*)g.A + (size_t)nxt.pm * tstep : cA; const char* nB = has_next ? (const char*)g.Bt + (size_t)nxt.pn * tstep : cB;
        for (int t = 0; t < nt; t += 2) {
            const bool last = (t == nt - 2);
            const char* a1 = cA + (size_t)(t + 1) * kstep;
            const char* a2 = last ? nA : cA + (size_t)(t + 2) * kstep; const char* b2 = last ? nB : cB + (size_t)(t + 2) * kstep;
            const char* a3 = a2 + kstep; const char* b3 = b2 + kstep;
            if (last && has_next) S.a_ready(nxt);
            if constexpr (SP2) {
            PG8_LDB(B0, 0, 0); PG8_LDB(B1, 0, 1); PG8_SCHED; PG8_LDA(At, 0, 0); PG8_STAGE(PG8_SA(1, 1), a1 + hstep, voffA);
            PG8_WAIT_V(8); PG8_WAIT_L(0); PG8_BAR; PG8_MMA(0, 0, At, B0); PG8_MMA(0, 1, At, B1); PG8_BAR; PG8_SCHED;
            PG8_LDA(At, 0, 1); PG8_STAGE(PG8_SB(0, 0), b2, voffB); PG8_STAGE(PG8_SB(0, 1), b2 + hstep, voffB); PG8_STAGE(PG8_SA(0, 0), a2, voffA);
            PG8_WAIT_V(8); PG8_WAIT_L(0); PG8_BAR; PG8_MMA(1, 0, At, B0); PG8_MMA(1, 1, At, B1); PG8_BAR; PG8_SCHED;
            PG8_LDB(B0, 1, 0); PG8_LDB(B1, 1, 1); PG8_SCHED; PG8_LDA(At, 1, 0); PG8_STAGE(PG8_SA(0, 1), a2 + hstep, voffA);
            PG8_WAIT_V(8); PG8_WAIT_L(0); PG8_BAR; PG8_MMA(0, 0, At, B0); PG8_MMA(0, 1, At, B1); PG8_BAR; PG8_SCHED;
            PG8_LDA(At, 1, 1); PG8_STAGE(PG8_SB(1, 0), b3, voffB); PG8_STAGE(PG8_SB(1, 1), b3 + hstep, voffB); PG8_STAGE(PG8_SA(1, 0), a3, voffA);
            PG8_WAIT_V(8); PG8_WAIT_L(0); PG8_BAR; PG8_MMA(1, 0, At, B0); PG8_MMA(1, 1, At, B1); PG8_BAR; PG8_SCHED;
            } else {
            PG8_LDB(B0, 0, 0); PG8_SCHED; PG8_LDA(At, 0, 0); PG8_STAGE(PG8_SA(1, 1), a1 + hstep, voffA);
            PG8_WAIT_L(8); PG8_BAR; PG8_WAIT_L(0); PG8_MMA(0, 0, At, B0); PG8_BAR; PG8_SCHED;
            PG8_LDB(B1, 0, 1); PG8_STAGE(PG8_SB(0, 0), b2, voffB);
            PG8_BAR; PG8_WAIT_L(0); PG8_MMA(0, 1, At, B1); PG8_BAR;
            PG8_LDA(At, 0, 1); PG8_STAGE(PG8_SA(0, 0), a2, voffA);
            PG8_BAR; PG8_WAIT_L(0); PG8_MMA(1, 0, At, B0); PG8_BAR; PG8_SCHED;
            PG8_STAGE(PG8_SB(0, 1), b2 + hstep, voffB);
            PG8_WAIT_V(6); PG8_BAR; PG8_MMA(1, 1, At, B1); PG8_BAR;
            PG8_LDB(B0, 1, 0); PG8_SCHED; PG8_LDA(At, 1, 0); PG8_STAGE(PG8_SA(0, 1), a2 + hstep, voffA);
            PG8_WAIT_L(8); PG8_BAR; PG8_WAIT_L(0); PG8_MMA(0, 0, At, B0); PG8_BAR; PG8_SCHED;
            PG8_LDB(B1, 1, 1); PG8_STAGE(PG8_SB(1, 0), b3, voffB);
            PG8_BAR; PG8_WAIT_L(0); PG8_MMA(0, 1, At, B1); PG8_BAR;
            PG8_LDA(At, 1, 1); PG8_STAGE(PG8_SA(1, 0), a3, voffA);
            PG8_BAR; PG8_WAIT_L(0); PG8_MMA(1, 0, At, B0); PG8_BAR; PG8_SCHED;
            PG8_STAGE(PG8_SB(1, 1), b3 + hstep, voffB);
            PG8_WAIT_V(6); PG8_BAR; PG8_MMA(1, 1, At, B1); PG8_BAR;
            }
        }
        if constexpr (ALIGN_EPI) { if (wr == 0) PG8_BAR; }
        if constexpr (!Epi::AFTER_DRAIN) { E(acc, cur, wr, wc, fr, fq); S.done(cur); }
        if (!has_next) break;
#pragma unroll
        for (int a = 0; a < 2; ++a)
#pragma unroll
            for (int b = 0; b < 2; ++b)
#pragma unroll
                for (int m = 0; m < 4; ++m)
#pragma unroll
                    for (int n = 0; n < 2; ++n) acc[a][b][m][n] = (f32x4){0.f, 0.f, 0.f, 0.f};
        cur = nxt; cA = nA; cB = nB; ++ui;
        if constexpr (ALIGN_EPI) { if (wr == 1) PG8_BAR; }
    }
    PG8_WAIT_V(0);
    if constexpr (!ALIGN_EPI) { if (wr == 0) PG8_BAR; }
    PG8_BAR;
    if constexpr (Epi::AFTER_DRAIN) { E.fused(acc, cur, wr, wc, fr, fq, lds, wid, lane); S.done(cur); }
#undef PG8_SA
#undef PG8_SB
#undef PG8_STAGE
#undef PG8_LDA
#undef PG8_LDB
#undef PG8_MMA
#undef PG8_WAIT_V
#undef PG8_WAIT_L
#undef PG8_BAR
#undef PG8_SCHED
}
}
#define GAS __attribute__((address_space(1)))
#define LAS __attribute__((address_space(3)))
typedef unsigned short bf16;
typedef unsigned v4u __attribute__((ext_vector_type(4)));
typedef float f32x4 __attribute__((ext_vector_type(4)));
typedef short bf16x8 __attribute__((ext_vector_type(8)));
typedef GAS unsigned gu32;
typedef GAS unsigned long long gu64;
#define RLX_AGENT __ATOMIC_RELAXED, __HIP_MEMORY_SCOPE_AGENT
#define LDS_WAIT() asm volatile("s_waitcnt lgkmcnt(0)" ::: "memory")
#define VM_WAIT() asm volatile("s_waitcnt vmcnt(0)" ::: "memory")
__device__ __forceinline__ unsigned long long rt() { return __builtin_amdgcn_s_memrealtime(); }
__device__ __forceinline__ unsigned f2bf(float f) { unsigned u = __builtin_bit_cast(unsigned, f); return (u + 0x7fffu + ((u >> 16) & 1u)) >> 16; }
__device__ __forceinline__ unsigned pk2(float lo, float hi) { return f2bf(lo) | (f2bf(hi) << 16); }
#define XB_TMO      128
#define XB_XCNT(j)  (256  + 64 * (j))
#define XB_XSUB(j)  (1280 + 64 * (j))
#define XB_XGEN(j)  (2304 + 64 * (j))
#define XB_TOP      3328
#define XB_TOPGEN   3392
#define XCD_BAR_WORDS 3456
#define XB_SPIN_CAP (1u << 18)

__device__ __forceinline__ unsigned xb_ld(unsigned* p)              { return __hip_atomic_load(p, __ATOMIC_RELAXED, __HIP_MEMORY_SCOPE_AGENT); }
__device__ __forceinline__ unsigned xb_add(unsigned* p, unsigned v) { return __hip_atomic_fetch_add(p, v, __ATOMIC_RELAXED, __HIP_MEMORY_SCOPE_AGENT); }
__device__ __forceinline__ unsigned xb_xcc_id() { return (unsigned)__builtin_amdgcn_s_getreg((3 << 11) | 20) & 0xFu; }
#define XB_SPIN(cond, bar) do { unsigned _sp = 0; while (cond) { __builtin_amdgcn_s_sleep(1); \
    if ((++_sp & 255u) == 0u) { if (xb_ld(&(bar)[XB_TMO])) break; if (_sp > XB_SPIN_CAP) { atomicAdd(&(bar)[XB_TMO], 1u); break; } } } } while (0)

struct XcdBarrier {
    unsigned* bar; unsigned x;
    volatile LAS unsigned* st;
};

__device__ __forceinline__ XcdBarrier xcd_barrier_post(unsigned* bar, volatile LAS unsigned* st) {
    XcdBarrier b; b.bar = bar; b.x = xb_xcc_id(); b.st = st;
    if (threadIdx.x == 0) (void)xb_add(&bar[XB_XCNT(b.x)], 1u);
    return b;
}
__device__ __forceinline__ void xcd_barrier_complete(unsigned* bar, unsigned x, unsigned& nloc, unsigned& nx) {
    const unsigned G = gridDim.x * gridDim.y * gridDim.z;
    unsigned sum, cnt, mine, sp = 0u;
    for (;;) {
        sum = 0u; cnt = 0u; mine = 0u;
#pragma unroll
        for (unsigned j = 0; j < 16; ++j) { const unsigned c = xb_ld(&bar[XB_XCNT(j)]); sum += c; cnt += (c > 0u) ? 1u : 0u; mine = (j == x) ? c : mine; }
        if (sum == G) break;
        __builtin_amdgcn_s_sleep(1);
        if ((++sp & 255u) == 0u) { if (xb_ld(&bar[XB_TMO])) break; if (sp > XB_SPIN_CAP) { atomicAdd(&bar[XB_TMO], 1u); break; } }
    }
    nloc = mine > 0u ? mine : 1u; nx = cnt > 0u ? cnt : 1u;
}

__device__ __forceinline__ void xcd_barrier(const XcdBarrier& b) {
    asm volatile("s_waitcnt vmcnt(0)" ::: "memory");
    __syncthreads();
    if (threadIdx.x == 0) {
        unsigned* bar = b.bar;
        __builtin_amdgcn_s_waitcnt(0);
        unsigned nloc = b.st[0], nx = b.st[1];
        if (nloc == 0u) { xcd_barrier_complete(bar, b.x, nloc, nx); b.st[0] = nloc; b.st[1] = nx; }
        const unsigned old = xb_add(&bar[XB_XSUB(b.x)], 1u);
        const unsigned gen = old / nloc;
        if (old + 1u == (gen + 1u) * nloc) {
            __builtin_amdgcn_fence(__ATOMIC_RELEASE, "agent");
            asm volatile("s_waitcnt vmcnt(0)" ::: "memory");
            const unsigned og = xb_add(&bar[XB_TOP], 1u);
            const unsigned tg = og / nx;
            if (og + 1u == (tg + 1u) * nx) xb_add(&bar[XB_TOPGEN], 1u);
            else XB_SPIN(xb_ld(&bar[XB_TOPGEN]) == tg, bar);
            __builtin_amdgcn_fence(__ATOMIC_ACQUIRE, "agent");
            xb_add(&bar[XB_XGEN(b.x)], 1u);
            asm volatile("s_waitcnt vmcnt(0)" ::: "memory");
        } else {
            XB_SPIN(xb_ld(&bar[XB_XGEN(b.x)]) == gen, bar);
            __builtin_amdgcn_fence(__ATOMIC_ACQUIRE, "agent");
            asm volatile("s_waitcnt vmcnt(0)" ::: "memory");
        }
    }
    __syncthreads();
}

#ifndef PG8_SP2
#define PG8_SP2 true
#endif
#ifndef PG8_ALIGN
#define PG8_ALIGN true
#endif

constexpr int DM = 1024, NBATCH = 8, SEQ = 2048, DEPTH = 4, CTXL = 256, NMOD = 9, DFF = 2816, NHEAD = 16, NKV = 4, HD = 64;
constexpr int ML = NBATCH * SEQ;
constexpr int MC = NBATCH * CTXL;
constexpr int MA = ML + MC;
constexpr int KEYS = SEQ + CTXL;
constexpr int NQKV = DM + 2 * NKV * HD;
constexpr float RMS_EPS = 1e-6f;
constexpr float LOG2E = 1.4426950408889634f;
constexpr int NWAVES = 8;

constexpr size_t MiB = 1u << 20;
constexpr size_t WS_CTL = 0, CTL_ZERO_BYTES = 1 * MiB;
constexpr size_t WS_MOD = 1 * MiB;
constexpr size_t WS_ROPE = 3 * MiB;
constexpr size_t WS_WGU = 4 * MiB;
constexpr size_t WS_WDN = 92 * MiB;
constexpr size_t WS_WCI = 136 * MiB;
constexpr size_t WS_WCO = 148 * MiB;
constexpr size_t WS_WQKV = 152 * MiB;
constexpr size_t WS_WO = 158 * MiB;
constexpr size_t WS_X = 162 * MiB;
constexpr size_t WS_H = 234 * MiB;
constexpr size_t WS_Y = 270 * MiB;
constexpr size_t WS_ACT = 306 * MiB;
constexpr size_t WS_MIXQ = WS_ACT;
constexpr size_t WS_MIXK = WS_ACT + 36 * MiB;
constexpr size_t WS_MIXV = WS_ACT + 45 * MiB;
constexpr size_t WS_MIXA = 405 * MiB;
constexpr size_t WS_END = 441 * MiB;
constexpr int CW_BAR = 4096;

constexpr int RING_BYTES = 131072;
constexpr int LDSCTL_OFF = RING_BYTES, MISC_OFF = LDSCTL_OFF + 320;
constexpr int LDS_BYTES = 147456;

typedef unsigned u32x2 __attribute__((ext_vector_type(2)));
typedef unsigned u32x4 __attribute__((ext_vector_type(4)));
typedef float f32x16 __attribute__((ext_vector_type(16)));

__device__ __forceinline__ float wave_sum(float v) {
#pragma unroll
    for (int o = 1; o < 64; o <<= 1) v += __shfl_xor(v, o);
    return v;
}
__device__ __forceinline__ float bf_lo(unsigned w) { return __uint_as_float(w << 16); }
__device__ __forceinline__ float bf_hi(unsigned w) { return __uint_as_float(w & 0xffff0000u); }

namespace pg8 {
template <int MODE  > struct EpiGated {
    static constexpr bool PERM = true, AFTER_DRAIN = false;
    bf16_t* P; int ldp; int nplain; bf16_t* O; int ldo;
    __device__ __forceinline__ void operator()(const f32x4 (&acc)[2][2][4][2], const Unit& u, int wr, int wc, int fr, int fq) const {
        const int row0 = u.pm * BM + wr * 64 + fr;
        if (u.pn < nplain) {
            const int col0 = u.pn * BM + wc * 32 + 8 * fq;
#pragma unroll
            for (int ai = 0; ai < 2; ++ai)
#pragma unroll
                for (int m = 0; m < 4; ++m) { bf16_t* rowp = P + (size_t)(row0 + ai * HALF + m * 16) * ldp + col0;
#pragma unroll
                    for (int bj = 0; bj < 2; ++bj) { const f32x4 v0 = acc[ai][bj][m][0], v1 = acc[ai][bj][m][1];
                        u32x4 w; w.x = cvt_pk_bf16(v0[0], v0[1]); w.y = cvt_pk_bf16(v0[2], v0[3]); w.z = cvt_pk_bf16(v1[0], v1[1]); w.w = cvt_pk_bf16(v1[2], v1[3]);
                        *(u32x4*)(rowp + bj * HALF) = w; } }
        } else {
            const int col0 = (u.pn - nplain) * HALF + wc * 32 + 8 * fq;
#pragma unroll
            for (int ai = 0; ai < 2; ++ai)
#pragma unroll
                for (int m = 0; m < 4; ++m) { bf16_t* rowp = O + (size_t)(row0 + ai * HALF + m * 16) * ldo + col0;
                    float r[8];
#pragma unroll
                    for (int n = 0; n < 2; ++n)
#pragma unroll
                        for (int i = 0; i < 4; ++i) { const float g = acc[ai][0][m][n][i], up = acc[ai][1][m][n][i];
                            if (MODE == 0) { const float e = __expf(-g); r[n * 4 + i] = g * __builtin_amdgcn_rcpf(1.0f + e) * up; }
                            else r[n * 4 + i] = g * up; }
                    u32x4 w; w.x = cvt_pk_bf16(r[0], r[1]); w.y = cvt_pk_bf16(r[2], r[3]); w.z = cvt_pk_bf16(r[4], r[5]); w.w = cvt_pk_bf16(r[6], r[7]);
                    *(u32x4*)rowp = w; }
        }
    }
};
struct EpiQKV {
    static constexpr bool PERM = false, AFTER_DRAIN = false;
    bf16_t* Q; bf16_t* K; bf16_t* Vt; const float* cosT; const float* sinT;
    __device__ __forceinline__ void operator()(const f32x4 (&acc)[2][2][4][2], const Unit& u, int wr, int wc, int fr, int fq) const {
        const int rowt = u.pm * BM;
        const bool lat = rowt < ML;
        if (u.pn < 5) {
            const bool isq = u.pn < 4;
            const float sc = isq ? 0.125f * LOG2E : 1.0f;
            const int a = wc & 1;
#pragma unroll
            for (int ai = 0; ai < 2; ++ai)
#pragma unroll
                for (int m = 0; m < 4; ++m) {
                    const int r = rowt + ai * HALF + wr * 64 + m * 16 + fr;
                    f32x4 cs = (f32x4){1.f, 1.f, 1.f, 1.f}, sn = (f32x4){0.f, 0.f, 0.f, 0.f};
                    if (lat) { const int s = r & (SEQ - 1); const int pos = a ? (s & 63) : (s >> 6);
                        cs = *(const f32x4*)(cosT + pos * 16 + 4 * fq); sn = *(const f32x4*)(sinT + pos * 16 + 4 * fq); }
#pragma unroll
                    for (int bj = 0; bj < 2; ++bj) {
                        const f32x4 x1 = acc[ai][bj][m][0], x2 = acc[ai][bj][m][1];
                        const f32x4 o1 = (x1 * cs - x2 * sn) * sc, o2 = (x2 * cs + x1 * sn) * sc;
                        u32x2 w1, w2; w1.x = cvt_pk_bf16(o1[0], o1[1]); w1.y = cvt_pk_bf16(o1[2], o1[3]); w2.x = cvt_pk_bf16(o2[0], o2[1]); w2.y = cvt_pk_bf16(o2[2], o2[3]);
                        const int cl = bj * HALF + wc * 32 + 4 * fq;
                        bf16_t* dst = isq ? (Q + (size_t)r * DM + u.pn * BM + cl) : (K + (size_t)r * 256 + cl);
                        *(u32x2*)dst = w1; *(u32x2*)(dst + 16) = w2;
                    }
                }
        } else {
            const int b = lat ? (rowt >> 11) : ((rowt - ML) >> 8);
            const int key0 = lat ? (rowt & (SEQ - 1)) : (SEQ + ((rowt - ML) & (CTXL - 1)));
#pragma unroll
            for (int ai = 0; ai < 2; ++ai)
#pragma unroll
                for (int m = 0; m < 4; ++m) {
                    const int key = key0 + ai * HALF + wr * 64 + m * 16 + fr;
#pragma unroll
                    for (int bj = 0; bj < 2; ++bj)
#pragma unroll
                        for (int n = 0; n < 2; ++n) {
                            const int cl = bj * HALF + wc * 32 + n * 16 + 4 * fq;
                            const f32x4 v = acc[ai][bj][m][n];
                            const unsigned p0 = cvt_pk_bf16(v[0], v[1]), p1 = cvt_pk_bf16(v[2], v[3]);
                            bf16_t* dst = Vt + ((size_t)(b * NKV) * HD + cl) * KEYS + key;
                            dst[0] = (bf16_t)(p0 & 0xffffu); dst[KEYS] = (bf16_t)(p0 >> 16); dst[2 * KEYS] = (bf16_t)(p1 & 0xffffu); dst[3 * KEYS] = (bf16_t)(p1 >> 16);
                        }
                }
        }
    }
};
struct EpiAll {
    static constexpr bool AFTER_DRAIN = false;
    int mode;
    bool perm;
    bf16_t* O1; bf16_t* O2; bf16_t* O3; int ld1; const float* cosT; const float* sinT;
    __device__ __forceinline__ void operator()(const f32x4 (&acc)[2][2][4][2], const Unit& u, int wr, int wc, int fr, int fq) const {
        if (mode == 3) { EpiQKV e{O1, O2, O3, cosT, sinT}; e(acc, u, wr, wc, fr, fq); }
        else if (mode == 1) { EpiGated<0> e{nullptr, 0, 0, O1, ld1}; e(acc, u, wr, wc, fr, fq); }
        else if (mode == 2) { EpiGated<1> e{O1, ld1, 4, O2, ld1}; e(acc, u, wr, wc, fr, fq); }
        else { EpiGated<1> e{O1, ld1, 1 << 30, nullptr, 0}; e(acc, u, wr, wc, fr, fq); }
    }
};
}

struct Args { const float* in[15]; float* out; unsigned char* ws; int ph_lo, ph_hi, use_bar, pad; };

__device__ __forceinline__ int dest_row(int mode, int n0) {
    if (mode == 0) return n0;
    if (mode == 1) { return (n0 < DFF) ? (n0 / 128) * 256 + (n0 % 128) : ((n0 - DFF) / 128) * 256 + 128 + ((n0 - DFF) % 128); }
    if (n0 < DM) return n0;
    if (n0 < 2 * DM) return DM + ((n0 - DM) / 128) * 256 + ((n0 - DM) % 128);
    return DM + ((n0 - 2 * DM) / 128) * 256 + 128 + ((n0 - 2 * DM) % 128);
}
__device__ __forceinline__ void p0_transpose_item(const float* W, int K, int N, bf16* WT, int mode, LAS float* scr, int item, int lane) {
    const int nblk = N / 32, kb = item / nblk, nb = item % nblk, k0 = 64 * kb, n0 = 32 * nb;
    const int d0 = dest_row(mode, n0);
#pragma unroll 8
    for (int i = 0; i < 32; ++i) { const int kk = 2 * i + (lane >> 5); scr[kk * 33 + (lane & 31)] = W[(size_t)(k0 + kk) * N + n0 + (lane & 31)]; }
    LDS_WAIT(); asm volatile("" ::: "memory");
    const int c = lane & 7;
#pragma unroll
    for (int j = 0; j < 4; ++j) { const int n = (lane >> 3) + 8 * j; const LAS float* s = scr + (8 * c) * 33 + n;
        v4u o; o.x = pk2(s[0 * 33], s[1 * 33]); o.y = pk2(s[2 * 33], s[3 * 33]); o.z = pk2(s[4 * 33], s[5 * 33]); o.w = pk2(s[6 * 33], s[7 * 33]);
        *(GAS v4u*)(WT + (size_t)(d0 + n) * K + k0 + 8 * c) = o; }
    LDS_WAIT(); asm volatile("" ::: "memory");
}

__device__ __forceinline__ void prologue_phase(const Args& a, LAS unsigned char* lds, int tid, int lane, int wave, int vcu, int G) {
    unsigned char* ws = a.ws;
    asm volatile("" : "+v"(tid), "+v"(lane));
    {
        LAS float* scr = (LAS float*)(lds + wave * 16384);
        const int gw = vcu * NWAVES + wave, NGW = G * NWAVES;
        constexpr int I_GU = (DM / 64) * (2 * DFF / 32), I_DN = (DFF / 64) * (DM / 32), I_CI = (DM / 64) * (3 * DM / 32), I_SQ = (DM / 64) * (DM / 32), I_QKV = (DM / 64) * (NQKV / 32);
        constexpr int NITEMS = 8 * I_GU + 8 * I_DN + 2 * I_CI + 2 * I_SQ + 2 * I_QKV + 2 * I_SQ;
        for (int it = gw; it < NITEMS; it += NGW) {
            int r = it;
            if (r < 8 * I_GU) { const int mi = r / I_GU; p0_transpose_item(a.in[7] + (size_t)mi * DM * 2 * DFF, DM, 2 * DFF, (bf16*)(ws + WS_WGU) + (size_t)mi * 2 * DFF * DM, 1, scr, r % I_GU, lane); continue; } r -= 8 * I_GU;
            if (r < 8 * I_DN) { const int mi = r / I_DN; p0_transpose_item(a.in[8] + (size_t)mi * DFF * DM, DFF, DM, (bf16*)(ws + WS_WDN) + (size_t)mi * DM * DFF, 0, scr, r % I_DN, lane); continue; } r -= 8 * I_DN;
            if (r < 2 * I_CI) { const int mi = r / I_CI; p0_transpose_item(a.in[9] + (size_t)mi * DM * 3 * DM, DM, 3 * DM, (bf16*)(ws + WS_WCI) + (size_t)mi * 3 * DM * DM, 2, scr, r % I_CI, lane); continue; } r -= 2 * I_CI;
            if (r < 2 * I_SQ) { const int mi = r / I_SQ; p0_transpose_item(a.in[11] + (size_t)mi * DM * DM, DM, DM, (bf16*)(ws + WS_WCO) + (size_t)mi * DM * DM, 0, scr, r % I_SQ, lane); continue; } r -= 2 * I_SQ;
            if (r < 2 * I_QKV) { const int mi = r / I_QKV; p0_transpose_item(a.in[12] + (size_t)mi * DM * NQKV, DM, NQKV, (bf16*)(ws + WS_WQKV) + (size_t)mi * NQKV * DM, 0, scr, r % I_QKV, lane); continue; } r -= 2 * I_QKV;
            { const int mi = r / I_SQ; p0_transpose_item(a.in[13] + (size_t)mi * DM * DM, DM, DM, (bf16*)(ws + WS_WO) + (size_t)mi * DM * DM, 0, scr, r % I_SQ, lane); }
        }
    }
    __syncthreads();
    if (blockIdx.x == 0) {
        float* cosT = (float*)(ws + WS_ROPE); float* sinT = cosT + 64 * 16;
        for (int i = tid; i < 64 * 16; i += NWAVES * 64) { const int pos = i >> 4, q = i & 15;
            const float inv = powf(10000.0f, -(float)q / 16.0f); const float ang = (float)pos * inv; cosT[i] = cosf(ang); sinT[i] = sinf(ang); }
    }
    {
        LAS float* st = (LAS float*)lds;
        LAS float* red = (LAS float*)(lds + 40960);
        for (int i = tid; i < 9 * DM; i += NWAVES * 64) { const float v = (i < 8 * DM) ? a.in[1][i] : a.in[3][i - 8 * DM]; st[i] = v / (1.0f + __expf(-v)); }
        __syncthreads();
        const int cq = lane & 31, kh = lane >> 5;
        for (int item = blockIdx.x; item < DEPTH * 72; item += G) {
            const int l = item / 72, cb = item % 72;
            const float* wp = a.in[4] + ((size_t)l * DM) * (NMOD * DM) + cb * 128 + cq * 4;
            f32x4 accm[9];
#pragma unroll
            for (int mr = 0; mr < 9; ++mr) accm[mr] = (f32x4){0.f, 0.f, 0.f, 0.f};
#pragma unroll 4
            for (int it = 0; it < 64; ++it) { const int k = 128 * wave + 2 * it + kh;
                const f32x4 wv = *(const f32x4*)(wp + (size_t)k * (NMOD * DM));
#pragma unroll
                for (int mr = 0; mr < 9; ++mr) { const float s = st[mr * DM + k]; accm[mr] += wv * s; } }
#pragma unroll
            for (int mr = 0; mr < 9; ++mr)
#pragma unroll
                for (int i = 0; i < 4; ++i) { float v = accm[mr][i]; v += __shfl_xor(v, 32); if (lane < 32) red[(wave * 32 + cq) * 36 + mr * 4 + i] = v; }
            __syncthreads();
            for (int o = tid; o < 32 * 36; o += NWAVES * 64) { const int q = o / 36, v = o % 36, mr = v >> 2, i = v & 3;
                float s = 0.f;
#pragma unroll
                for (int w = 0; w < 8; ++w) s += red[(w * 32 + q) * 36 + v];
                const int col = cb * 128 + q * 4 + i;
                ((float*)(ws + WS_MOD))[((size_t)(l * 9 + mr)) * (NMOD * DM) + col] = s + a.in[5][(size_t)l * NMOD * DM + col]; }
            __syncthreads();
        }
    }
}

__device__ __forceinline__ void norm_phase(const float* xin_lat, const float* xin_ctx, float* xout_lat, float* xout_ctx, const bf16* Y, const float* gpost, int gate_idx, float w,
                                           const float* gpre, int shift_idx, int scale_idx, bf16* H, const float* modpost, const float* modpre, int nrows, int lane, int gw, int NGW) {
    asm volatile("" : "+v"(lane));
    const int rpw = (nrows + NGW - 1) / NGW;
    const int r0 = gw * rpw, r1 = min(nrows, r0 + rpw);
    f32x4 A[4], Bc[4], Sh[4];
#pragma unroll
    for (int j = 0; j < 4; ++j) { A[j] = (f32x4){0.f, 0.f, 0.f, 0.f}; Bc[j] = A[j]; Sh[j] = A[j]; }
    int cur = -1;
    for (int r = r0; r < r1; ++r) {
        const int mr = r < ML ? (r >> 11) : 8;
        if (mr != cur) { cur = mr; const float* mp = modpost + (size_t)mr * (NMOD * DM); const float* mq = modpre + (size_t)mr * (NMOD * DM);
#pragma unroll
            for (int j = 0; j < 4; ++j) { const int c = 4 * lane + 256 * j;
                if (Y) { const f32x4 g = *(const f32x4*)(gpost + c), gt = *(const f32x4*)(mp + gate_idx * DM + c); A[j] = g * gt * w; }
                if (H) { const f32x4 g = *(const f32x4*)(gpre + c), sc = *(const f32x4*)(mq + scale_idx * DM + c); Bc[j] = g * (sc + 1.0f); Sh[j] = *(const f32x4*)(mq + shift_idx * DM + c); } } }
        const float* xr = r < ML ? xin_lat + (size_t)r * DM : xin_ctx + (size_t)(r - ML) * DM;
        f32x4 xv[4];
#pragma unroll
        for (int j = 0; j < 4; ++j) xv[j] = *(const f32x4*)(xr + 4 * lane + 256 * j);
        if (Y) {
            f32x4 yv[4]; float ss = 0.f;
#pragma unroll
            for (int j = 0; j < 4; ++j) { const u32x2 wv = *(const u32x2*)(Y + (size_t)r * DM + 4 * lane + 256 * j);
                yv[j] = (f32x4){bf_lo(wv.x), bf_hi(wv.x), bf_lo(wv.y), bf_hi(wv.y)}; ss += (yv[j][0] * yv[j][0] + yv[j][1] * yv[j][1]) + (yv[j][2] * yv[j][2] + yv[j][3] * yv[j][3]); }
            const float rstd = __builtin_amdgcn_rsqf(wave_sum(ss) * (1.0f / DM) + RMS_EPS);
#pragma unroll
            for (int j = 0; j < 4; ++j) xv[j] += A[j] * (yv[j] * rstd);
            float* xo = r < ML ? xout_lat + (size_t)r * DM : xout_ctx + (size_t)(r - ML) * DM;
#pragma unroll
            for (int j = 0; j < 4; ++j) *(f32x4*)(xo + 4 * lane + 256 * j) = xv[j];
        }
        if (H) {
            float ss = 0.f;
#pragma unroll
            for (int j = 0; j < 4; ++j) ss += (xv[j][0] * xv[j][0] + xv[j][1] * xv[j][1]) + (xv[j][2] * xv[j][2] + xv[j][3] * xv[j][3]);
            const float rstd = __builtin_amdgcn_rsqf(wave_sum(ss) * (1.0f / DM) + RMS_EPS);
#pragma unroll
            for (int j = 0; j < 4; ++j) { const f32x4 h = xv[j] * rstd * Bc[j] + Sh[j]; u32x2 wv; wv.x = pg8::cvt_pk_bf16(h[0], h[1]); wv.y = pg8::cvt_pk_bf16(h[2], h[3]);
                *(u32x2*)(H + (size_t)r * DM + 4 * lane + 256 * j) = wv; }
        }
    }
}

__device__ __forceinline__ void unpack8(const v4u w, float (&f)[8]) { f[0] = bf_lo(w.x); f[1] = bf_hi(w.x); f[2] = bf_lo(w.y); f[3] = bf_hi(w.y); f[4] = bf_lo(w.z); f[5] = bf_hi(w.z); f[6] = bf_lo(w.w); f[7] = bf_hi(w.w); }
__device__ __forceinline__ void zero8(float (&f)[8]) {
#pragma unroll
    for (int i = 0; i < 8; ++i) f[i] = 0.f; }
__device__ __forceinline__ void conv_phase(const bf16* Bb, const bf16* CU, const float* cw, bf16* P, int nrows, int lane, int gw, int NGW) {
    asm volatile("" : "+v"(lane));
    const int rpw = (nrows + NGW - 1) / NGW;
    const int r0 = gw * rpw, r1 = min(nrows, r0 + rpw);
    if (r0 >= r1) return;
    float w0[2][8], w1[2][8], w2[2][8];
#pragma unroll
    for (int j = 0; j < 2; ++j)
#pragma unroll
        for (int i = 0; i < 8; ++i) { const int c = 512 * j + 8 * lane + i; w0[j][i] = cw[c]; w1[j][i] = cw[DM + c]; w2[j][i] = cw[2 * DM + c]; }
    float pv[2][8], cv[2][8], nv[2][8];
#pragma unroll
    for (int j = 0; j < 2; ++j) {
        if (r0 > 0) unpack8(*(const v4u*)(CU + (size_t)(r0 - 1) * DM + 512 * j + 8 * lane), pv[j]); else zero8(pv[j]);
        unpack8(*(const v4u*)(CU + (size_t)r0 * DM + 512 * j + 8 * lane), cv[j]);
    }
    for (int r = r0; r < r1; ++r) {
        const bool sstart = r < ML ? ((r & (SEQ - 1)) == 0) : ((r & (CTXL - 1)) == 0);
        const bool send = r < ML ? ((r & (SEQ - 1)) == SEQ - 1) : ((r & (CTXL - 1)) == CTXL - 1);
        const bool havenext = (r + 1) < MA;
#pragma unroll
        for (int j = 0; j < 2; ++j) {
            if (havenext) unpack8(*(const v4u*)(CU + (size_t)(r + 1) * DM + 512 * j + 8 * lane), nv[j]); else zero8(nv[j]);
            float bb[8]; unpack8(*(const v4u*)(Bb + (size_t)r * DM + 512 * j + 8 * lane), bb);
            float o[8];
#pragma unroll
            for (int i = 0; i < 8; ++i) { const float p = sstart ? 0.f : pv[j][i], nx = send ? 0.f : nv[j][i]; o[i] = bb[i] * (w0[j][i] * p + w1[j][i] * cv[j][i] + w2[j][i] * nx); }
            v4u w; w.x = pg8::cvt_pk_bf16(o[0], o[1]); w.y = pg8::cvt_pk_bf16(o[2], o[3]); w.z = pg8::cvt_pk_bf16(o[4], o[5]); w.w = pg8::cvt_pk_bf16(o[6], o[7]);
            *(v4u*)(P + (size_t)r * DM + 512 * j + 8 * lane) = w;
#pragma unroll
            for (int i = 0; i < 8; ++i) { pv[j][i] = cv[j][i]; cv[j][i] = nv[j][i]; }
        }
    }
}

constexpr int ATT_KST = 144, ATT_VST = 264, ATT_VOFF = 128 * ATT_KST, ATT_QOFF = 40960;
typedef unsigned long long u64;
__device__ __forceinline__ void attn_unit(LAS unsigned char* lds, const bf16* Q, const bf16* Kb, const bf16* Vt, bf16* O, const float* sink,
                                          int b, int hk, int nblk, bool latq, int tid) {
    asm volatile("" : "+v"(tid));
    const int lane = tid & 63, wave = __builtin_amdgcn_readfirstlane(tid >> 6);
    const int g = wave >> 1, wq = wave & 1, head = hk * 4 + g, r32 = lane & 31, hi = lane >> 5;
    const int qrow0 = (latq ? b * SEQ + nblk * 128 : ML + b * CTXL + nblk * 128) + wq * 64;
    const float sk = sink[head] * LOG2E;
    const bf16* vbase = Vt + ((size_t)(b * NKV + hk) * HD) * KEYS;
#pragma unroll 1
    for (int qt = 0; qt < 2; ++qt) {
        pg8::bf16x8 qf[4];
#pragma unroll
        for (int ks = 0; ks < 4; ++ks) qf[ks] = *(const pg8::bf16x8*)(Q + (size_t)(qrow0 + 32 * qt + r32) * DM + head * HD + 16 * ks + 8 * hi);
        f32x16 o[2];
#pragma unroll
        for (int dt = 0; dt < 2; ++dt)
#pragma unroll
            for (int i = 0; i < 16; ++i) o[dt][i] = 0.f;
        float mrun = sk, lrun = hi == 0 ? 1.f : 0.f;
        const int dlq = 4 * hi - (wq * 64 + 32 * qt + r32);
#pragma unroll 1
        for (int c = latq ? 0 : 3; c < 5; ++c) {
            const int kb = nblk - 1 + c;
            if (c < 3 && (kb < 0 || kb >= SEQ / 128)) continue;
            const int krow0 = c < 3 ? b * SEQ + kb * 128 : ML + b * CTXL + (c - 3) * 128;
            const int vkey0 = c < 3 ? kb * 128 : SEQ + (c - 3) * 128;
            __syncthreads();
            { const int row = tid >> 2, pc = tid & 3; const v4u* src = (const v4u*)(Kb + (size_t)(krow0 + row) * 256 + hk * HD + pc * 16);
              const v4u k0 = src[0], k1 = src[1]; LAS v4u* dst = (LAS v4u*)(lds + row * ATT_KST + pc * 32); dst[0] = k0; dst[1] = k1; }
            { const int d = tid >> 3, pc = tid & 7; const v4u* src = (const v4u*)(vbase + (size_t)d * KEYS + vkey0 + pc * 16);
              const v4u v0 = src[0], v1 = src[1]; LAS u64* dst = (LAS u64*)(lds + ATT_VOFF + d * ATT_VST + pc * 32);
              dst[0] = ((u64)v0.y << 32) | v0.x; dst[1] = ((u64)v0.w << 32) | v0.z; dst[2] = ((u64)v1.y << 32) | v1.x; dst[3] = ((u64)v1.w << 32) | v1.z; }
            __syncthreads();
            const int sgn = (c == 0) ? 1 : -1;
            const int dls = sgn * dlq;
#pragma unroll
            for (int kh = 0; kh < 2; ++kh) {
                f32x16 s[2];
#pragma unroll
                for (int k2 = 0; k2 < 2; ++k2) {
                    const int kt = 2 * kh + k2;
#pragma unroll
                    for (int i = 0; i < 16; ++i) s[k2][i] = 0.f;
#pragma unroll
                    for (int ks = 0; ks < 4; ++ks) { const pg8::bf16x8 kf = *(const LAS pg8::bf16x8*)(lds + (32 * kt + r32) * ATT_KST + (16 * ks + 8 * hi) * 2);
                        s[k2] = __builtin_amdgcn_mfma_f32_32x32x16_bf16(kf, qf[ks], s[k2], 0, 0, 0); }
                }
                if (c == 0 || c == 2) {
#pragma unroll
                    for (int k2 = 0; k2 < 2; ++k2)
#pragma unroll
                        for (int i = 0; i < 16; ++i) { const int cj = 32 * (2 * kh + k2) + (i & 3) + 8 * (i >> 2); const int t = min(dls + sgn * cj, 0); s[k2][i] = fmaf((float)t, 1e30f, s[k2][i]); }
                }
                float mx = s[0][0];
#pragma unroll
                for (int k2 = 0; k2 < 2; ++k2)
#pragma unroll
                    for (int i = 0; i < 16; ++i) mx = fmaxf(mx, s[k2][i]);
                mx = fmaxf(mx, __shfl_xor(mx, 32));
                const float mnew = fmaxf(mrun, mx), alpha = __builtin_amdgcn_exp2f(mrun - mnew);
                mrun = mnew;
                float ls = 0.f;
#pragma unroll
                for (int k2 = 0; k2 < 2; ++k2)
#pragma unroll
                    for (int i = 0; i < 16; ++i) { s[k2][i] = __builtin_amdgcn_exp2f(s[k2][i] - mnew); ls += s[k2][i]; }
                lrun = lrun * alpha + ls;
#pragma unroll
                for (int dt = 0; dt < 2; ++dt)
#pragma unroll
                    for (int i = 0; i < 16; ++i) o[dt][i] *= alpha;
#pragma unroll
                for (int k2 = 0; k2 < 2; ++k2)
#pragma unroll
                    for (int s2 = 0; s2 < 2; ++s2) {
                        const int kt = 2 * kh + k2;
                        u32x4 pw; pw.x = pg8::cvt_pk_bf16(s[k2][8 * s2 + 0], s[k2][8 * s2 + 1]); pw.y = pg8::cvt_pk_bf16(s[k2][8 * s2 + 2], s[k2][8 * s2 + 3]);
                        pw.z = pg8::cvt_pk_bf16(s[k2][8 * s2 + 4], s[k2][8 * s2 + 5]); pw.w = pg8::cvt_pk_bf16(s[k2][8 * s2 + 6], s[k2][8 * s2 + 7]);
                        const pg8::bf16x8 pf = __builtin_bit_cast(pg8::bf16x8, pw);
#pragma unroll
                        for (int dt = 0; dt < 2; ++dt) {
                            const LAS unsigned char* vp = lds + ATT_VOFF + (32 * dt + r32) * ATT_VST + (32 * kt + 16 * s2 + 4 * hi) * 2;
                            const u64 a0 = *(const LAS u64*)vp, a1 = *(const LAS u64*)(vp + 16);
                            u32x4 vw; vw.x = (unsigned)a0; vw.y = (unsigned)(a0 >> 32); vw.z = (unsigned)a1; vw.w = (unsigned)(a1 >> 32);
                            o[dt] = __builtin_amdgcn_mfma_f32_32x32x16_bf16(__builtin_bit_cast(pg8::bf16x8, vw), pf, o[dt], 0, 0, 0);
                        }
                    }
                __builtin_amdgcn_sched_barrier(0);
            }
        }
        const float lt = lrun + __shfl_xor(lrun, 32), inv = 1.0f / lt;
        bf16* orow = O + (size_t)(qrow0 + 32 * qt + r32) * DM + head * HD;
#pragma unroll
        for (int dt = 0; dt < 2; ++dt)
#pragma unroll
            for (int q4 = 0; q4 < 4; ++q4) { u32x2 w; w.x = pg8::cvt_pk_bf16(o[dt][4 * q4 + 0] * inv, o[dt][4 * q4 + 1] * inv); w.y = pg8::cvt_pk_bf16(o[dt][4 * q4 + 2] * inv, o[dt][4 * q4 + 3] * inv);
                *(u32x2*)(orow + 32 * dt + 8 * q4 + 4 * hi) = w; }
    }
}

constexpr int N_PHASES = 2 + 10 * DEPTH;
#ifndef MK_EN
#define MK_EN 0xff
#endif
#define EN(x) (((MK_EN) >> (x)) & 1)
__global__ void __launch_bounds__(NWAVES * 64, 2) mk_fwd(Args args) {
    extern __shared__ __attribute__((aligned(16))) unsigned char lds_raw[];
    LAS unsigned char* lds = (LAS unsigned char*)lds_raw;
    volatile LAS unsigned* MISC = (volatile LAS unsigned*)(lds + MISC_OFF);
    const int tid = threadIdx.x, lane = tid & 63, wave = __builtin_amdgcn_readfirstlane(tid >> 6);
    const int G = gridDim.x; const int bx = blockIdx.x; const int vcu = (G % 8 == 0) ? (bx % 8) * (G / 8) + bx / 8 : bx;
    const int gw = vcu * NWAVES + wave, NGW = G * NWAVES;
    unsigned char* ws = args.ws;
    for (int u = tid; u < (LDS_BYTES - LDSCTL_OFF) / 4; u += NWAVES * 64) ((LAS unsigned*)(lds + LDSCTL_OFF))[u] = 0u;
    __syncthreads();
    XcdBarrier bar; bar.bar = (unsigned*)(ws + WS_CTL) + CW_BAR; bar.x = 0; bar.st = nullptr;
    if (args.use_bar) bar = xcd_barrier_post((unsigned*)(ws + WS_CTL) + CW_BAR, MISC + 8);

    bf16* const Hb = (bf16*)(ws + WS_H); bf16* const Yb = (bf16*)(ws + WS_Y); bf16* const ACT = (bf16*)(ws + WS_ACT);
    bf16* const MQ = (bf16*)(ws + WS_MIXQ); bf16* const MK = (bf16*)(ws + WS_MIXK); bf16* const MV = (bf16*)(ws + WS_MIXV); bf16* const MA_ = (bf16*)(ws + WS_MIXA);
    float* const X = (float*)(ws + WS_X);
    const float* const MOD = (const float*)(ws + WS_MOD);
    const float* const cosT = (const float*)(ws + WS_ROPE); const float* const sinT = cosT + 64 * 16;

    if (args.ph_lo == 0) {
        if (EN(0)) prologue_phase(args, lds, tid, lane, wave, vcu, G);
        if (args.ph_hi > 1) cg::this_grid().sync();
    }
    for (int ph = max(args.ph_lo, 1); ph < args.ph_hi; ++ph) {
        {
            const int l = ph == 1 ? -1 : (ph - 2) / 10, st = ph == 1 ? 9 : (ph - 2) % 10;
            const bool last = (l == DEPTH - 1), attn = (l & 1) == 1; const int j = l >> 1;
            const int Mpost = last ? ML : MA;
            const float* gl = args.in[6] + (long)l * 6 * DM;
            const float* modl = MOD + (long)l * 9 * (NMOD * DM);
            if (st == 0 || st == 7 || st == 1 || st == 8 || st == 5 || st == 3) {
                const bool gu = (st == 0 || st == 7), dn = (st == 1 || st == 8);
                const int f = st >= 7 ? 1 : 0;
                const int M = (st <= 3) ? MA : Mpost;
                const int N = gu ? 2 * DFF : (st == 3 ? (attn ? NQKV : 3 * DM) : DM);
                const int K = dn ? DFF : DM;
                const bf16* A = gu || st == 3 ? Hb : (dn ? ACT : MA_);
                const bf16* Bt = gu ? (const bf16*)(ws + WS_WGU) + (size_t)(l * 2 + f) * 2 * DFF * DM
                               : dn ? (const bf16*)(ws + WS_WDN) + (size_t)(l * 2 + f) * DM * DFF
                               : st == 3 ? (attn ? (const bf16*)(ws + WS_WQKV) + (size_t)j * NQKV * DM : (const bf16*)(ws + WS_WCI) + (size_t)j * 3 * DM * DM)
                               : (attn ? (const bf16*)(ws + WS_WO) + (size_t)j * DM * DM : (const bf16*)(ws + WS_WCO) + (size_t)j * DM * DM);
                const int mode = gu ? 1 : (st == 3 ? (attn ? 3 : 2) : 0);
                pg8::Gemm g{A, Bt, M, N, K}; pg8::StaticOrder S; S.init(M, N, G, bx);
                pg8::EpiAll E{mode, mode != 3, gu ? ACT : (st == 3 ? MQ : Yb), MK, MV, gu ? DFF : DM, cosT, sinT};
                if (EN(2)) pg8::gemm_phase<pg8::EpiAll, pg8::StaticOrder, PG8_ALIGN, PG8_SP2>(lds, g, S, E);
            } else if (st == 2 || st == 6 || st == 9) {
                const bool first = (l == 0 && st == 2), init = (l < 0);
                const float* xin_lat = (first || init) ? args.in[0] : X; const float* xin_ctx = (first || init) ? args.in[2] : X + (size_t)ML * DM;
                float* xout_lat = (last && st == 9) ? args.out : X; float* xout_ctx = X + (size_t)ML * DM;
                const bf16* Yp = init ? nullptr : Yb;
                const float* gpost = gl + (st == 2 ? 1 : (st == 6 ? 3 : 5)) * DM; const int gate_idx = st == 2 ? 2 : (st == 6 ? 5 : 8); const float w = st == 6 ? 1.0f : 0.5f;
                const float* gpre = st == 9 ? gl + 6 * DM : gl + st * DM;
                const float* gpre2 = st == 6 ? gl + 4 * DM : gpre;
                const int shift_idx = st == 2 ? 3 : (st == 6 ? 6 : 0);
                bf16* Hp = (last && st == 9) ? nullptr : Hb;
                const float* modpre = st == 9 ? modl + (size_t)9 * (NMOD * DM) : modl;
                const int nrows = (st == 2 || init) ? MA : Mpost;
                if (EN(1)) norm_phase(xin_lat, xin_ctx, xout_lat, xout_ctx, Yp, gpost, gate_idx, w, gpre2, shift_idx, shift_idx + 1, Hp, modl, modpre, nrows, lane, gw, NGW);
            } else {
                if (attn) {
                    const int nlat = NBATCH * NKV * (SEQ / 128), nctx = last ? 0 : NBATCH * NKV * (CTXL / 128);
                    for (int u = vcu; u < nlat + nctx; u += G) {
                        const bool latq = u < nlat; const int v = latq ? u : u - nlat; const int nb = latq ? SEQ / 128 : CTXL / 128;
                        const int nblk = v % nb, hk = (v / nb) % NKV, b = v / (nb * NKV);
                        if (EN(6)) attn_unit(lds, MQ, MK, MV, MA_, args.in[14] + (size_t)j * NHEAD, b, hk, nblk, latq, tid);
                    }
                } else {
                    if (EN(7)) conv_phase(MQ, MK, args.in[10] + (size_t)j * 3 * DM, MA_, MA, lane, gw, NGW);
                }
            }
        }
        if (ph + 1 < args.ph_hi) xcd_barrier(bar);
    }
}

extern "C" void kernel_launch(void* const* d_in, const int* in_sizes, int n_in, void* d_out, int out_size, void* d_ws, size_t ws_size, hipStream_t stream) {
    static int grid = 0;
    if (grid == 0) {
        if (n_in != 15 || in_sizes[0] != ML * DM || out_size != ML * DM || ws_size < WS_END) { fprintf(stderr, "kernel_launch: unexpected shapes (n_in %d, in0 %d, out %d, ws %zu)\n", n_in, n_in > 0 ? in_sizes[0] : -1, out_size, ws_size); grid = -1; return; }
        int dev = 0, cus = 0, per_cu = 0;
        if (hipGetDevice(&dev) != hipSuccess || hipDeviceGetAttribute(&cus, hipDeviceAttributeMultiprocessorCount, dev) != hipSuccess) { grid = -1; return; }
        if (hipFuncSetAttribute((const void*)mk_fwd, hipFuncAttributeMaxDynamicSharedMemorySize, LDS_BYTES) != hipSuccess) { fprintf(stderr, "kernel_launch: hipFuncSetAttribute failed\n"); grid = -1; return; }
        if (hipOccupancyMaxActiveBlocksPerMultiprocessor(&per_cu, (const void*)mk_fwd, NWAVES * 64, LDS_BYTES) != hipSuccess || per_cu < 1) { fprintf(stderr, "kernel_launch: occupancy query says %d\n", per_cu); per_cu = 1; }
        (void)hipGetLastError();
        grid = cus;
    }
    if (grid < 0) return;
    (void)hipMemsetAsync((char*)d_ws + WS_CTL, 0, CTL_ZERO_BYTES, stream);
    Args a{};
    for (int i = 0; i < 15; ++i) a.in[i] = (const float*)d_in[i];
    a.out = (float*)d_out; a.ws = (unsigned char*)d_ws;
#ifndef MK_MULTI
#define MK_MULTI 1
#endif
#if MK_MULTI
    for (int p = 0; p < N_PHASES; ++p) { a.ph_lo = p; a.ph_hi = p + 1; a.use_bar = 0; hipLaunchKernelGGL(mk_fwd, dim3(grid), dim3(NWAVES * 64), LDS_BYTES, stream, a); }
#else
    a.ph_lo = 0; a.ph_hi = N_PHASES; a.use_bar = 1;
    void* kargs[] = {&a};
    hipError_t e = hipLaunchCooperativeKernel((const void*)mk_fwd, dim3(grid), dim3(NWAVES * 64), kargs, LDS_BYTES, stream);
    if (e != hipSuccess) fprintf(stderr, "kernel_launch: cooperative launch failed: %s (grid %d)\n", hipGetErrorString(e), grid);
#endif
}
```

```cpp
#include <hip/hip_runtime.h>
#include <hip/hip_cooperative_groups.h>
#include <cstdio>
#include <cstdint>
namespace cg = cooperative_groups;
namespace pg8 {
#define PG8_LAS __attribute__((address_space(3)))
typedef unsigned short bf16_t;
typedef short bf16x8 __attribute__((ext_vector_type(8)));
typedef float f32x4 __attribute__((ext_vector_type(4)));
typedef unsigned u32x4 __attribute__((ext_vector_type(4)));
constexpr int BM = 256, BK = 64, HALF = 128, HTB = HALF * BK * 2  , STAGE_BYTES = 8 * HTB, NXCD = 8, WGM = 8;

__host__ __device__ __forceinline__ int lds_byte(int r, int c) { const int st = (r >> 4) * 2 + (c >> 5), rr = r & 15, cc = c & 31, ob = rr * 64 + cc * 2; return st * 1024 + (ob ^ (((ob >> 9) & 1) << 5)); }
__host__ __device__ __forceinline__ void stage_rc(int b, int& R, int& C) { const int st = b / 1024, sb = b % 1024, swz = sb ^ (((sb >> 9) & 1) << 5); R = (st >> 1) * 16 + swz / 64; C = (st & 1) * 32 + (swz % 64) / 2; }
__host__ __device__ __forceinline__ int perm32(int rho) { const int n = rho >> 4, i = rho & 15; return 8 * (i >> 2) + 4 * n + (i & 3); }

struct Unit { int pm, pn; };
struct Gemm { const bf16_t* A; const bf16_t* Bt; int M, N, K; };

struct StaticOrder {
    int nM, nN, nwg, G, c;
    __host__ __device__ void init(int M, int N, int G_, int c_) { nM = M / BM; nN = N / BM; nwg = nM * nN; G = G_; c = c_; }
    __host__ __device__ bool next(int i, Unit& u) const {
        const long L = (long)i * G + c; if (L >= nwg) return false;
        int wgid = (int)L; { const int q = nwg / NXCD, r = nwg % NXCD, xcd = wgid % NXCD, off = wgid / NXCD; wgid = (xcd < r ? xcd * (q + 1) : r * (q + 1) + (xcd - r) * q) + off; }
        const int nig = WGM * nN, gid = wgid / nig, fm = gid * WGM, gsz = (nM - fm) < WGM ? (nM - fm) : WGM;
        u.pm = fm + ((wgid % nig) % gsz); u.pn = (wgid % nig) / gsz; return true;
    }
    __device__ __forceinline__ void a_ready(const Unit&) const {}
    __device__ __forceinline__ void done(const Unit&) const {}
};

__device__ __forceinline__ unsigned cvt_pk_bf16(float lo, float hi) { unsigned r; asm volatile("v_cvt_pk_bf16_f32 %0, %1, %2" : "=v"(r) : "v"(lo), "v"(hi)); return r; }
typedef float f32x2 __attribute__((ext_vector_type(2)));
__device__ __forceinline__ f32x2 gelu_pk(f32x2 v) {
    const f32x2 av = __builtin_elementwise_abs(v), d = av * 0.2316418882f + 1.0f;
    f32x2 t; t.x = __builtin_amdgcn_rcpf(d.x); t.y = __builtin_amdgcn_rcpf(d.y);
    f32x2 q = t * 0.5307027145f + (-0.7265760135f); q = q * t + 0.7107068705f; q = q * t + (-0.142248368f); q = q * t + 0.127414796f; q = q * t;
    const f32x2 s = (v * v) * (-0.72134752044f);
    f32x2 e; e.x = __builtin_amdgcn_exp2f(s.x); e.y = __builtin_amdgcn_exp2f(s.y);
    const f32x2 m = v * (q * e), r = v - m;
    f32x2 o; o.x = v.x < 0.f ? m.x : r.x; o.y = v.y < 0.f ? m.y : r.y; return o;
}

template <int ACT  > struct EpiBf16 {
    static constexpr bool PERM = true, AFTER_DRAIN = false; static_assert(ACT == 0 || ACT == 1, "EpiBf16: ACT is 0 (none) or 1 (gelu_pk)");
    bf16_t* O; int ldc; const float* bias; int split_cols; size_t split_stride; float scale0;
    __device__ __forceinline__ void operator()(const f32x4 (&acc)[2][2][4][2], const Unit& u, int wr, int wc, int fr, int fq) const {
        const int row0 = u.pm * BM + wr * 64 + fr; int colt = u.pn * BM; bf16_t* base = O;
        float sc = 1.f; if (split_cols) { const int t = colt / split_cols; base += (size_t)t * split_stride; colt -= t * split_cols; if (t == 0) sc = scale0; }
        const int col0 = colt + wc * 32 + 8 * fq, bcol0 = u.pn * BM + wc * 32 + 8 * fq;
        f32x4 bv[2][2];
#pragma unroll
        for (int bj = 0; bj < 2; ++bj)
#pragma unroll
            for (int n = 0; n < 2; ++n) bv[bj][n] = bias ? *(const f32x4*)(bias + bcol0 + bj * HALF + 4 * n) : (f32x4){0.f, 0.f, 0.f, 0.f};
#pragma unroll
        for (int ai = 0; ai < 2; ++ai)
#pragma unroll
            for (int m = 0; m < 4; ++m) { bf16_t* rowp = base + (size_t)(row0 + ai * HALF + m * 16) * ldc + col0;
#pragma unroll
                for (int bj = 0; bj < 2; ++bj) { f32x4 v0 = acc[ai][bj][m][0] + bv[bj][0], v1 = acc[ai][bj][m][1] + bv[bj][1];
                    if (ACT == 1) { f32x2 a = gelu_pk((f32x2){v0[0], v0[1]}), b = gelu_pk((f32x2){v0[2], v0[3]}), c = gelu_pk((f32x2){v1[0], v1[1]}), d = gelu_pk((f32x2){v1[2], v1[3]});
                        v0 = (f32x4){a.x, a.y, b.x, b.y}; v1 = (f32x4){c.x, c.y, d.x, d.y}; }
                    v0 = v0 * sc; v1 = v1 * sc; u32x4 w; w.x = cvt_pk_bf16(v0[0], v0[1]); w.y = cvt_pk_bf16(v0[2], v0[3]); w.z = cvt_pk_bf16(v1[0], v1[1]); w.w = cvt_pk_bf16(v1[2], v1[3]);
                    *(u32x4*)(rowp + bj * HALF) = w; } }
    }
};
template <class Epi, class Sched, bool ALIGN_EPI = false, bool SP2 = false>
__device__ __forceinline__ void gemm_phase(PG8_LAS unsigned char* lds, const Gemm g, const Sched& S, const Epi& E) {
    const int tid = threadIdx.x, wid = __builtin_amdgcn_readfirstlane(tid >> 6), lane = tid & 63, wr = wid >> 2, wc = wid & 3, fr = lane & 15, fq = lane >> 4;
    const int K = g.K, nt = K / BK;
    unsigned voffA[2], voffB[2];
#pragma unroll
    for (int i = 0; i < 2; ++i) { int R, C; stage_rc(tid * 16 + i * 8192, R, C); const int Rb = E.perm ? ((R & ~31) + perm32(R & 31)) : R;
        voffA[i] = (unsigned)(R * K + C) * 2u; voffB[i] = (unsigned)(Rb * K + C) * 2u; }
    const size_t kstep = (size_t)(BK * 2);
    const size_t hstep = (size_t)HALF * K * 2;
    const size_t tstep = 2 * hstep;
    const unsigned ldsw = (unsigned)wid * 1024u;
    const int aoff = lds_byte(wr * 64 + fr, fq * 8), boff = lds_byte(wc * 32 + fr, fq * 8);
#define PG8_SA(b, h) (((b) * 2 + (h)) * HTB)
#define PG8_SB(b, h) ((4 + (b) * 2 + (h)) * HTB)
#define PG8_STAGE(bufoff, gbase, voff) do { _Pragma("unroll") for (int _i = 0; _i < 2; ++_i) \
        __builtin_amdgcn_global_load_lds((const unsigned*)((const char*)(gbase) + (voff)[_i]), (PG8_LAS unsigned*)(lds + (bufoff) + ldsw + _i * 8192), 16, 0, 0); } while (0)
#define PG8_LDA(dst, b, h) do { _Pragma("unroll") for (int m = 0; m < 4; ++m) _Pragma("unroll") for (int k = 0; k < 2; ++k) dst[m][k] = *(const PG8_LAS bf16x8*)(lds + PG8_SA(b, h) + aoff + m * 2048 + k * 1024); } while (0)
#define PG8_LDB(dst, b, h) do { _Pragma("unroll") for (int n = 0; n < 2; ++n) _Pragma("unroll") for (int k = 0; k < 2; ++k) dst[n][k] = *(const PG8_LAS bf16x8*)(lds + PG8_SB(b, h) + boff + n * 2048 + k * 1024); } while (0)
#define PG8_MMA(ai, bj, At, Bt) do { __builtin_amdgcn_s_setprio(1); _Pragma("unroll") for (int m = 0; m < 4; ++m) _Pragma("unroll") for (int n = 0; n < 2; ++n) _Pragma("unroll") for (int k = 0; k < 2; ++k) \
        acc[ai][bj][m][n] = __builtin_amdgcn_mfma_f32_16x16x32_bf16(Bt[n][k], At[m][k], acc[ai][bj][m][n], 0, 0, 0); __builtin_amdgcn_s_setprio(0); } while (0)
#define PG8_WAIT_V(n) asm volatile("s_waitcnt vmcnt(" #n ")" ::: "memory")
#define PG8_WAIT_L(n) asm volatile("s_waitcnt lgkmcnt(" #n ")" ::: "memory")
#define PG8_BAR __builtin_amdgcn_s_barrier()
#define PG8_SCHED __builtin_amdgcn_sched_barrier(0)
    Unit cur, nxt; int ui = 0;
    if (!S.next(0, cur)) return;
    f32x4 acc[2][2][4][2];
#pragma unroll
    for (int a = 0; a < 2; ++a)
#pragma unroll
        for (int b = 0; b < 2; ++b)
#pragma unroll
            for (int m = 0; m < 4; ++m)
#pragma unroll
                for (int n = 0; n < 2; ++n) acc[a][b][m][n] = (f32x4){0.f, 0.f, 0.f, 0.f};
    bf16x8 At[4][2], B0[2][2], B1[2][2];
    const char* cA = (const char*)g.A + (size_t)cur.pm * tstep; const char* cB = (const char*)g.Bt + (size_t)cur.pn * tstep;
    S.a_ready(cur);
    if constexpr (SP2) {
        PG8_STAGE(PG8_SB(0, 0), cB, voffB); PG8_STAGE(PG8_SB(0, 1), cB + hstep, voffB); PG8_STAGE(PG8_SA(0, 0), cA, voffA); PG8_STAGE(PG8_SA(0, 1), cA + hstep, voffA);
        if (wr == 1) PG8_BAR;
        PG8_WAIT_V(2); PG8_BAR;
        PG8_STAGE(PG8_SB(1, 0), cB + kstep, voffB); PG8_STAGE(PG8_SA(1, 0), cA + kstep, voffA); PG8_STAGE(PG8_SB(1, 1), cB + hstep + kstep, voffB);
        PG8_WAIT_V(6); PG8_BAR;
    } else {
        PG8_STAGE(PG8_SB(0, 0), cB, voffB); PG8_STAGE(PG8_SA(0, 0), cA, voffA); PG8_STAGE(PG8_SB(0, 1), cB + hstep, voffB); PG8_STAGE(PG8_SA(0, 1), cA + hstep, voffA);
        if (wr == 1) PG8_BAR;
        PG8_WAIT_V(4); PG8_BAR;
        PG8_STAGE(PG8_SB(1, 0), cB + kstep, voffB); PG8_STAGE(PG8_SA(1, 0), cA + kstep, voffA); PG8_STAGE(PG8_SB(1, 1), cB + hstep + kstep, voffB);
        PG8_WAIT_V(6); PG8_BAR;
    }
    for (;;) {
        const bool has_next = S.next(ui + 1, nxt);
        const char* nA = has_next ? (const char*)g.A + (size_t)nxt.pm * tstep : cA; const char* nB = has_next ? (const char*)g.Bt + (size_t)nxt.pn * tstep : cB;
        for (int t = 0; t < nt; t += 2) {
            const bool last = (t == nt - 2);
            const char* a1 = cA + (size_t)(t + 1) * kstep;
            const char* a2 = last ? nA : cA + (size_t)(t + 2) * kstep; const char* b2 = last ? nB : cB + (size_t)(t + 2) * kstep;
            const char* a3 = a2 + kstep; const char* b3 = b2 + kstep;
            if (last && has_next) S.a_ready(nxt);
            if constexpr (SP2) {
            PG8_LDB(B0, 0, 0); PG8_LDB(B1, 0, 1); PG8_SCHED; PG8_LDA(At, 0, 0); PG8_STAGE(PG8_SA(1, 1), a1 + hstep, voffA);
            PG8_WAIT_V(8); PG8_WAIT_L(0); PG8_BAR; PG8_MMA(0, 0, At, B0); PG8_MMA(0, 1, At, B1); PG8_BAR; PG8_SCHED;
            PG8_LDA(At, 0, 1); PG8_STAGE(PG8_SB(0, 0), b2, voffB); PG8_STAGE(PG8_SB(0, 1), b2 + hstep, voffB); PG8_STAGE(PG8_SA(0, 0), a2, voffA);
            PG8_WAIT_V(8); PG8_WAIT_L(0); PG8_BAR; PG8_MMA(1, 0, At, B0); PG8_MMA(1, 1, At, B1); PG8_BAR; PG8_SCHED;
            PG8_LDB(B0, 1, 0); PG8_LDB(B1, 1, 1); PG8_SCHED; PG8_LDA(At, 1, 0); PG8_STAGE(PG8_SA(0, 1), a2 + hstep, voffA);
            PG8_WAIT_V(8); PG8_WAIT_L(0); PG8_BAR; PG8_MMA(0, 0, At, B0); PG8_MMA(0, 1, At, B1); PG8_BAR; PG8_SCHED;
            PG8_LDA(At, 1, 1); PG8_STAGE(PG8_SB(1, 0), b3, voffB); PG8_STAGE(PG8_SB(1, 1), b3 + hstep, voffB); PG8_STAGE(PG8_SA(1, 0), a3, voffA);
            PG8_WAIT_V(8); PG8_WAIT_L(0); PG8_BAR; PG8_MMA(1, 0, At, B0); PG8_MMA(1, 1, At, B1); PG8_BAR; PG8_SCHED;
            } else {
            PG8_LDB(B0, 0, 0); PG8_SCHED; PG8_LDA(At, 0, 0); PG8_STAGE(PG8_SA(1, 1), a1 + hstep, voffA);
            PG8_WAIT_L(8); PG8_BAR; PG8_WAIT_L(0); PG8_MMA(0, 0, At, B0); PG8_BAR; PG8_SCHED;
            PG8_LDB(B1, 0, 1); PG8_STAGE(PG8_SB(0, 0), b2, voffB);
            PG8_BAR; PG8_WAIT_L(0); PG8_MMA(0, 1, At, B1); PG8_BAR;
            PG8_LDA(At, 0, 1); PG8_STAGE(PG8_SA(0, 0), a2, voffA);
            PG8_BAR; PG8_WAIT_L(0); PG8_MMA(1, 0, At, B0); PG8_BAR; PG8_SCHED;
            PG8_STAGE(PG8_SB(0, 1), b2 + hstep, voffB);
            PG8_WAIT_V(6); PG8_BAR; PG8_MMA(1, 1, At, B1); PG8_BAR;
            PG8_LDB(B0, 1, 0); PG8_SCHED; PG8_LDA(At, 1, 0); PG8_STAGE(PG8_SA(0, 1), a2 + hstep, voffA);
            PG8_WAIT_L(8); PG8_BAR; PG8_WAIT_L(0); PG8_MMA(0, 0, At, B0); PG8_BAR; PG8_SCHED;
            PG8_LDB(B1, 1, 1); PG8_STAGE(PG8_SB(1, 0), b3, voffB);
            PG8_BAR; PG8_WAIT_L(0); PG8_MMA(0, 1, At, B1); PG8_BAR;
            PG8_LDA(At, 1, 1); PG8_STAGE(PG8_SA(1, 0), a3, voffA);
            PG8_BAR; PG8_WAIT_L(0); PG8_MMA(1, 0, At, B0); PG8_BAR; PG8_SCHED;
            PG8_STAGE(PG8_SB(1, 1), b3 + hstep, voffB);
            PG8_WAIT_V(6); PG8_BAR; PG8_MMA(1, 1, At, B1); PG8_BAR;
            }
        }
        if constexpr (ALIGN_EPI) { if (wr == 0) PG8_BAR; }
        if constexpr (!Epi::AFTER_DRAIN) { E(acc, cur, wr, wc, fr, fq); S.done(cur); }
        if (!has_next) break;
#pragma unroll
        for (int a = 0; a < 2; ++a)
#pragma unroll
            for (int b = 0; b < 2; ++b)
#pragma unroll
                for (int m = 0; m < 4; ++m)
#pragma unroll
                    for (int n = 0; n < 2; ++n) acc[a][b][m][n] = (f32x4){0.f, 0.f, 0.f, 0.f};
        cur = nxt; cA = nA; cB = nB; ++ui;
        if constexpr (ALIGN_EPI) { if (wr == 1) PG8_BAR; }
    }
    PG8_WAIT_V(0);
    if constexpr (!ALIGN_EPI) { if (wr == 0) PG8_BAR; }
    PG8_BAR;
    if constexpr (Epi::AFTER_DRAIN) { E.fused(acc, cur, wr, wc, fr, fq, lds, wid, lane); S.done(cur); }
#undef PG8_SA
#undef PG8_SB
#undef PG8_STAGE
#undef PG8_LDA
#undef PG8_LDB
#undef PG8_MMA
#undef PG8_WAIT_V
#undef PG8_WAIT_L
#undef PG8_BAR
#undef PG8_SCHED
}
}
#define GAS __attribute__((address_space(1)))
#define LAS __attribute__((address_space(3)))
typedef unsigned short bf16;
typedef unsigned v4u __attribute__((ext_vector_type(4)));
typedef float f32x4 __attribute__((ext_vector_type(4)));
typedef short bf16x8 __attribute__((ext_vector_type(8)));
typedef GAS unsigned gu32;
typedef GAS unsigned long long gu64;
#define RLX_AGENT __ATOMIC_RELAXED, __HIP_MEMORY_SCOPE_AGENT
#define LDS_WAIT() asm volatile("s_waitcnt lgkmcnt(0)" ::: "memory")
#define VM_WAIT() asm volatile("s_waitcnt vmcnt(0)" ::: "memory")
__device__ __forceinline__ unsigned long long rt() { return __builtin_amdgcn_s_memrealtime(); }
__device__ __forceinline__ unsigned f2bf(float f) { unsigned u = __builtin_bit_cast(unsigned, f); return (u + 0x7fffu + ((u >> 16) & 1u)) >> 16; }
__device__ __forceinline__ unsigned pk2(float lo, float hi) { return f2bf(lo) | (f2bf(hi) << 16); }
#define XB_TMO      128
#define XB_XCNT(j)  (256  + 64 * (j))
#define XB_XSUB(j)  (1280 + 64 * (j))
#define XB_XGEN(j)  (2304 + 64 * (j))
#define XB_TOP      3328
#define XB_TOPGEN   3392
#define XCD_BAR_WORDS 3456
#define XB_SPIN_CAP (1u << 18)

__device__ __forceinline__ unsigned xb_ld(unsigned* p)              { return __hip_atomic_load(p, __ATOMIC_RELAXED, __HIP_MEMORY_SCOPE_AGENT); }
__device__ __forceinline__ unsigned xb_add(unsigned* p, unsigned v) { return __hip_atomic_fetch_add(p, v, __ATOMIC_RELAXED, __HIP_MEMORY_SCOPE_AGENT); }
__device__ __forceinline__ unsigned xb_xcc_id() { return (unsigned)__builtin_amdgcn_s_getreg((3 << 11) | 20) & 0xFu; }
#define XB_SPIN(cond, bar) do { unsigned _sp = 0; while (cond) { __builtin_amdgcn_s_sleep(1); \
    if ((++_sp & 255u) == 0u) { if (xb_ld(&(bar)[XB_TMO])) break; if (_sp > XB_SPIN_CAP) { atomicAdd(&(bar)[XB_TMO], 1u); break; } } } } while (0)

struct XcdBarrier {
    unsigned* bar; unsigned x;
    volatile LAS unsigned* st;
};

__device__ __forceinline__ XcdBarrier xcd_barrier_post(unsigned* bar, volatile LAS unsigned* st) {
    XcdBarrier b; b.bar = bar; b.x = xb_xcc_id(); b.st = st;
    if (threadIdx.x == 0) (void)xb_add(&bar[XB_XCNT(b.x)], 1u);
    return b;
}
__device__ __forceinline__ void xcd_barrier_complete(unsigned* bar, unsigned x, unsigned& nloc, unsigned& nx) {
    const unsigned G = gridDim.x * gridDim.y * gridDim.z;
    unsigned sum, cnt, mine, sp = 0u;
    for (;;) {
        sum = 0u; cnt = 0u; mine = 0u;
#pragma unroll
        for (unsigned j = 0; j < 16; ++j) { const unsigned c = xb_ld(&bar[XB_XCNT(j)]); sum += c; cnt += (c > 0u) ? 1u : 0u; mine = (j == x) ? c : mine; }
        if (sum == G) break;
        __builtin_amdgcn_s_sleep(1);
        if ((++sp & 255u) == 0u) { if (xb_ld(&bar[XB_TMO])) break; if (sp > XB_SPIN_CAP) { atomicAdd(&bar[XB_TMO], 1u); break; } }
    }
    nloc = mine > 0u ? mine : 1u; nx = cnt > 0u ? cnt : 1u;
}

__device__ __forceinline__ void xcd_barrier(const XcdBarrier& b) {
    asm volatile("s_waitcnt vmcnt(0)" ::: "memory");
    __syncthreads();
    if (threadIdx.x == 0) {
        unsigned* bar = b.bar;
        __builtin_amdgcn_s_waitcnt(0);
        unsigned nloc = b.st[0], nx = b.st[1];
        if (nloc == 0u) { xcd_barrier_complete(bar, b.x, nloc, nx); b.st[0] = nloc; b.st[1] = nx; }
        const unsigned old = xb_add(&bar[XB_XSUB(b.x)], 1u);
        const unsigned gen = old / nloc;
        if (old + 1u == (gen + 1u) * nloc) {
            __builtin_amdgcn_fence(__ATOMIC_RELEASE, "agent");
            asm volatile("s_waitcnt vmcnt(0)" ::: "memory");
            const unsigned og = xb_add(&bar[XB_TOP], 1u);
            const unsigned tg = og / nx;
            if (og + 1u == (tg + 1u) * nx) xb_add(&bar[XB_TOPGEN], 1u);
            else XB_SPIN(xb_ld(&bar[XB_TOPGEN]) == tg, bar);
            __builtin_amdgcn_fence(__ATOMIC_ACQUIRE, "agent");
            xb_add(&bar[XB_XGEN(b.x)], 1u);
            asm volatile("s_waitcnt vmcnt(0)" ::: "memory");
        } else {
            XB_SPIN(xb_ld(&bar[XB_XGEN(b.x)]) == gen, bar);
            __builtin_amdgcn_fence(__ATOMIC_ACQUIRE, "agent");
            asm volatile("s_waitcnt vmcnt(0)" ::: "memory");
        }
    }
    __syncthreads();
}

#ifndef PG8_SP2
#define PG8_SP2 true
#endif
#ifndef PG8_ALIGN
#define PG8_ALIGN true
#endif

constexpr int DM = 1024, NBATCH = 8, SEQ = 2048, DEPTH = 4, CTXL = 256, NMOD = 9, DFF = 2816, NHEAD = 16, NKV = 4, HD = 64;
constexpr int ML = NBATCH * SEQ;
constexpr int MC = NBATCH * CTXL;
constexpr int MA = ML + MC;
constexpr int KEYS = SEQ + CTXL;
constexpr int NQKV = DM + 2 * NKV * HD;
constexpr float RMS_EPS = 1e-6f;
constexpr float LOG2E = 1.4426950408889634f;
constexpr int NWAVES = 8;

constexpr size_t MiB = 1u << 20;
constexpr size_t WS_CTL = 0, CTL_ZERO_BYTES = 1 * MiB;
constexpr size_t WS_MOD = 1 * MiB;
constexpr size_t WS_ROPE = 3 * MiB;
constexpr size_t WS_WGU = 4 * MiB;
constexpr size_t WS_WDN = 92 * MiB;
constexpr size_t WS_WCI = 136 * MiB;
constexpr size_t WS_WCO = 148 * MiB;
constexpr size_t WS_WQKV = 152 * MiB;
constexpr size_t WS_WO = 158 * MiB;
constexpr size_t WS_X = 162 * MiB;
constexpr size_t WS_H = 234 * MiB;
constexpr size_t WS_Y = 270 * MiB;
constexpr size_t WS_ACT = 306 * MiB;
constexpr size_t WS_MIXQ = WS_ACT;
constexpr size_t WS_MIXK = WS_ACT + 36 * MiB;
constexpr size_t WS_MIXV = WS_ACT + 45 * MiB;
constexpr size_t WS_MIXA = 405 * MiB;
constexpr size_t WS_END = 441 * MiB;
constexpr int CW_BAR = 4096;

constexpr int RING_BYTES = 131072;
constexpr int LDSCTL_OFF = RING_BYTES, MISC_OFF = LDSCTL_OFF + 320;
constexpr int LDS_BYTES = 147456;

typedef unsigned u32x2 __attribute__((ext_vector_type(2)));
typedef unsigned u32x4 __attribute__((ext_vector_type(4)));
typedef float f32x16 __attribute__((ext_vector_type(16)));

__device__ __forceinline__ float wave_sum(float v) {
#pragma unroll
    for (int o = 1; o < 64; o <<= 1) v += __shfl_xor(v, o);
    return v;
}
__device__ __forceinline__ float bf_lo(unsigned w) { return __uint_as_float(w << 16); }
__device__ __forceinline__ float bf_hi(unsigned w) { return __uint_as_float(w & 0xffff0000u); }

namespace pg8 {
template <int MODE  > struct EpiGated {
    static constexpr bool PERM = true, AFTER_DRAIN = false;
    bf16_t* P; int ldp; int nplain; bf16_t* O; int ldo;
    __device__ __forceinline__ void operator()(const f32x4 (&acc)[2][2][4][2], const Unit& u, int wr, int wc, int fr, int fq) const {
        const int row0 = u.pm * BM + wr * 64 + fr;
        if (u.pn < nplain) {
            const int col0 = u.pn * BM + wc * 32 + 8 * fq;
#pragma unroll
            for (int ai = 0; ai < 2; ++ai)
#pragma unroll
                for (int m = 0; m < 4; ++m) { bf16_t* rowp = P + (size_t)(row0 + ai * HALF + m * 16) * ldp + col0;
#pragma unroll
                    for (int bj = 0; bj < 2; ++bj) { const f32x4 v0 = acc[ai][bj][m][0], v1 = acc[ai][bj][m][1];
                        u32x4 w; w.x = cvt_pk_bf16(v0[0], v0[1]); w.y = cvt_pk_bf16(v0[2], v0[3]); w.z = cvt_pk_bf16(v1[0], v1[1]); w.w = cvt_pk_bf16(v1[2], v1[3]);
                        *(u32x4*)(rowp + bj * HALF) = w; } }
        } else {
            const int col0 = (u.pn - nplain) * HALF + wc * 32 + 8 * fq;
#pragma unroll
            for (int ai = 0; ai < 2; ++ai)
#pragma unroll
                for (int m = 0; m < 4; ++m) { bf16_t* rowp = O + (size_t)(row0 + ai * HALF + m * 16) * ldo + col0;
                    float r[8];
#pragma unroll
                    for (int n = 0; n < 2; ++n)
#pragma unroll
                        for (int i = 0; i < 4; ++i) { const float g = acc[ai][0][m][n][i], up = acc[ai][1][m][n][i];
                            if (MODE == 0) { const float e = __expf(-g); r[n * 4 + i] = g * __builtin_amdgcn_rcpf(1.0f + e) * up; }
                            else r[n * 4 + i] = g * up; }
                    u32x4 w; w.x = cvt_pk_bf16(r[0], r[1]); w.y = cvt_pk_bf16(r[2], r[3]); w.z = cvt_pk_bf16(r[4], r[5]); w.w = cvt_pk_bf16(r[6], r[7]);
                    *(u32x4*)rowp = w; }
        }
    }
};
struct EpiQKV {
    static constexpr bool PERM = false, AFTER_DRAIN = false;
    bf16_t* Q; bf16_t* K; bf16_t* Vt; const float* cosT; const float* sinT;
    __device__ __forceinline__ void operator()(const f32x4 (&acc)[2][2][4][2], const Unit& u, int wr, int wc, int fr, int fq) const {
        const int rowt = u.pm * BM;
        const bool lat = rowt < ML;
        if (u.pn < 5) {
            const bool isq = u.pn < 4;
            const float sc = isq ? 0.125f * LOG2E : 1.0f;
            const int a = wc & 1;
#pragma unroll
            for (int ai = 0; ai < 2; ++ai)
#pragma unroll
                for (int m = 0; m < 4; ++m) {
                    const int r = rowt + ai * HALF + wr * 64 + m * 16 + fr;
                    f32x4 cs = (f32x4){1.f, 1.f, 1.f, 1.f}, sn = (f32x4){0.f, 0.f, 0.f, 0.f};
                    if (lat) { const int s = r & (SEQ - 1); const int pos = a ? (s & 63) : (s >> 6);
                        cs = *(const f32x4*)(cosT + pos * 16 + 4 * fq); sn = *(const f32x4*)(sinT + pos * 16 + 4 * fq); }
#pragma unroll
                    for (int bj = 0; bj < 2; ++bj) {
                        const f32x4 x1 = acc[ai][bj][m][0], x2 = acc[ai][bj][m][1];
                        const f32x4 o1 = (x1 * cs - x2 * sn) * sc, o2 = (x2 * cs + x1 * sn) * sc;
                        u32x2 w1, w2; w1.x = cvt_pk_bf16(o1[0], o1[1]); w1.y = cvt_pk_bf16(o1[2], o1[3]); w2.x = cvt_pk_bf16(o2[0], o2[1]); w2.y = cvt_pk_bf16(o2[2], o2[3]);
                        const int cl = bj * HALF + wc * 32 + 4 * fq;
                        bf16_t* dst = isq ? (Q + (size_t)r * DM + u.pn * BM + cl) : (K + (size_t)r * 256 + cl);
                        *(u32x2*)dst = w1; *(u32x2*)(dst + 16) = w2;
                    }
                }
        } else {
            const int b = lat ? (rowt >> 11) : ((rowt - ML) >> 8);
            const int key0 = lat ? (rowt & (SEQ - 1)) : (SEQ + ((rowt - ML) & (CTXL - 1)));
#pragma unroll
            for (int ai = 0; ai < 2; ++ai)
#pragma unroll
                for (int m = 0; m < 4; ++m) {
                    const int key = key0 + ai * HALF + wr * 64 + m * 16 + fr;
#pragma unroll
                    for (int bj = 0; bj < 2; ++bj)
#pragma unroll
                        for (int n = 0; n < 2; ++n) {
                            const int cl = bj * HALF + wc * 32 + n * 16 + 4 * fq;
                            const f32x4 v = acc[ai][bj][m][n];
                            const unsigned p0 = cvt_pk_bf16(v[0], v[1]), p1 = cvt_pk_bf16(v[2], v[3]);
                            bf16_t* dst = Vt + ((size_t)(b * NKV) * HD + cl) * KEYS + key;
                            dst[0] = (bf16_t)(p0 & 0xffffu); dst[KEYS] = (bf16_t)(p0 >> 16); dst[2 * KEYS] = (bf16_t)(p1 & 0xffffu); dst[3 * KEYS] = (bf16_t)(p1 >> 16);
                        }
                }
        }
    }
};
struct EpiAll {
    static constexpr bool AFTER_DRAIN = false;
    int mode;
    bool perm;
    bf16_t* O1; bf16_t* O2; bf16_t* O3; int ld1; const float* cosT; const float* sinT;
    __device__ __forceinline__ void operator()(const f32x4 (&acc)[2][2][4][2], const Unit& u, int wr, int wc, int fr, int fq) const {
        if (mode == 3) { EpiQKV e{O1, O2, O3, cosT, sinT}; e(acc, u, wr, wc, fr, fq); }
        else if (mode == 1) { EpiGated<0> e{nullptr, 0, 0, O1, ld1}; e(acc, u, wr, wc, fr, fq); }
        else if (mode == 2) { EpiGated<1> e{O1, ld1, 4, O2, ld1}; e(acc, u, wr, wc, fr, fq); }
        else { EpiGated<1> e{O1, ld1, 1 << 30, nullptr, 0}; e(acc, u, wr, wc, fr, fq); }
    }
};
}

struct Args { const float* in[15]; float* out; unsigned char* ws; int ph_lo, ph_hi, use_bar, pad; };

__device__ __forceinline__ int dest_row(int mode, int n0) {
    if (mode == 0) return n0;
    if (mode == 1) { return (n0 < DFF) ? (n0 / 128) * 256 + (n0 % 128) : ((n0 - DFF) / 128) * 256 + 128 + ((n0 - DFF) % 128); }
    if (n0 < DM) return n0;
    if (n0 < 2 * DM) return DM + ((n0 - DM) / 128) * 256 + ((n0 - DM) % 128);
    return DM + ((n0 - 2 * DM) / 128) * 256 + 128 + ((n0 - 2 * DM) % 128);
}
__device__ __forceinline__ void p0_transpose_item(const float* W, int K, int N, bf16* WT, int mode, LAS float* scr, int item, int lane) {
    const int nblk = N / 32, kb = item / nblk, nb = item % nblk, k0 = 64 * kb, n0 = 32 * nb;
    const int d0 = dest_row(mode, n0);
#pragma unroll 8
    for (int i = 0; i < 32; ++i) { const int kk = 2 * i + (lane >> 5); scr[kk * 33 + (lane & 31)] = W[(size_t)(k0 + kk) * N + n0 + (lane & 31)]; }
    LDS_WAIT(); asm volatile("" ::: "memory");
    const int c = lane & 7;
#pragma unroll
    for (int j = 0; j < 4; ++j) { const int n = (lane >> 3) + 8 * j; const LAS float* s = scr + (8 * c) * 33 + n;
        v4u o; o.x = pk2(s[0 * 33], s[1 * 33]); o.y = pk2(s[2 * 33], s[3 * 33]); o.z = pk2(s[4 * 33], s[5 * 33]); o.w = pk2(s[6 * 33], s[7 * 33]);
        *(GAS v4u*)(WT + (size_t)(d0 + n) * K + k0 + 8 * c) = o; }
    LDS_WAIT(); asm volatile("" ::: "memory");
}

__device__ __forceinline__ void prologue_phase(const Args& a, LAS unsigned char* lds, int tid, int lane, int wave, int vcu, int G) {
    unsigned char* ws = a.ws;
    asm volatile("" : "+v"(tid), "+v"(lane));
    {
        LAS float* scr = (LAS float*)(lds + wave * 16384);
        const int gw = vcu * NWAVES + wave, NGW = G * NWAVES;
        constexpr int I_GU = (DM / 64) * (2 * DFF / 32), I_DN = (DFF / 64) * (DM / 32), I_CI = (DM / 64) * (3 * DM / 32), I_SQ = (DM / 64) * (DM / 32), I_QKV = (DM / 64) * (NQKV / 32);
        constexpr int NITEMS = 8 * I_GU + 8 * I_DN + 2 * I_CI + 2 * I_SQ + 2 * I_QKV + 2 * I_SQ;
        for (int it = gw; it < NITEMS; it += NGW) {
            int r = it;
            if (r < 8 * I_GU) { const int mi = r / I_GU; p0_transpose_item(a.in[7] + (size_t)mi * DM * 2 * DFF, DM, 2 * DFF, (bf16*)(ws + WS_WGU) + (size_t)mi * 2 * DFF * DM, 1, scr, r % I_GU, lane); continue; } r -= 8 * I_GU;
            if (r < 8 * I_DN) { const int mi = r / I_DN; p0_transpose_item(a.in[8] + (size_t)mi * DFF * DM, DFF, DM, (bf16*)(ws + WS_WDN) + (size_t)mi * DM * DFF, 0, scr, r % I_DN, lane); continue; } r -= 8 * I_DN;
            if (r < 2 * I_CI) { const int mi = r / I_CI; p0_transpose_item(a.in[9] + (size_t)mi * DM * 3 * DM, DM, 3 * DM, (bf16*)(ws + WS_WCI) + (size_t)mi * 3 * DM * DM, 2, scr, r % I_CI, lane); continue; } r -= 2 * I_CI;
            if (r < 2 * I_SQ) { const int mi = r / I_SQ; p0_transpose_item(a.in[11] + (size_t)mi * DM * DM, DM, DM, (bf16*)(ws + WS_WCO) + (size_t)mi * DM * DM, 0, scr, r % I_SQ, lane); continue; } r -= 2 * I_SQ;
            if (r < 2 * I_QKV) { const int mi = r / I_QKV; p0_transpose_item(a.in[12] + (size_t)mi * DM * NQKV, DM, NQKV, (bf16*)(ws + WS_WQKV) + (size_t)mi * NQKV * DM, 0, scr, r % I_QKV, lane); continue; } r -= 2 * I_QKV;
            { const int mi = r / I_SQ; p0_transpose_item(a.in[13] + (size_t)mi * DM * DM, DM, DM, (bf16*)(ws + WS_WO) + (size_t)mi * DM * DM, 0, scr, r % I_SQ, lane); }
        }
    }
    __syncthreads();
    if (blockIdx.x == 0) {
        float* cosT = (float*)(ws + WS_ROPE); float* sinT = cosT + 64 * 16;
        for (int i = tid; i < 64 * 16; i += NWAVES * 64) { const int pos = i >> 4, q = i & 15;
            const float inv = powf(10000.0f, -(float)q / 16.0f); const float ang = (float)pos * inv; cosT[i] = cosf(ang); sinT[i] = sinf(ang); }
    }
    {
        LAS float* st = (LAS float*)lds;
        LAS float* red = (LAS float*)(lds + 40960);
        for (int i = tid; i < 9 * DM; i += NWAVES * 64) { const float v = (i < 8 * DM) ? a.in[1][i] : a.in[3][i - 8 * DM]; st[i] = v / (1.0f + __expf(-v)); }
        __syncthreads();
        const int cq = lane & 31, kh = lane >> 5;
        for (int item = blockIdx.x; item < DEPTH * 72; item += G) {
            const int l = item / 72, cb = item % 72;
            const float* wp = a.in[4] + ((size_t)l * DM) * (NMOD * DM) + cb * 128 + cq * 4;
            f32x4 accm[9];
#pragma unroll
            for (int mr = 0; mr < 9; ++mr) accm[mr] = (f32x4){0.f, 0.f, 0.f, 0.f};
#pragma unroll 4
            for (int it = 0; it < 64; ++it) { const int k = 128 * wave + 2 * it + kh;
                const f32x4 wv = *(const f32x4*)(wp + (size_t)k * (NMOD * DM));
#pragma unroll
                for (int mr = 0; mr < 9; ++mr) { const float s = st[mr * DM + k]; accm[mr] += wv * s; } }
#pragma unroll
            for (int mr = 0; mr < 9; ++mr)
#pragma unroll
                for (int i = 0; i < 4; ++i) { float v = accm[mr][i]; v += __shfl_xor(v, 32); if (lane < 32) red[(wave * 32 + cq) * 36 + mr * 4 + i] = v; }
            __syncthreads();
            for (int o = tid; o < 32 * 36; o += NWAVES * 64) { const int q = o / 36, v = o % 36, mr = v >> 2, i = v & 3;
                float s = 0.f;
#pragma unroll
                for (int w = 0; w < 8; ++w) s += red[(w * 32 + q) * 36 + v];
                const int col = cb * 128 + q * 4 + i;
                ((float*)(ws + WS_MOD))[((size_t)(l * 9 + mr)) * (NMOD * DM) + col] = s + a.in[5][(size_t)l * NMOD * DM + col]; }
            __syncthreads();
        }
    }
}

__device__ __forceinline__ void norm_phase(const float* xin_lat, const float* xin_ctx, float* xout_lat, float* xout_ctx, const bf16* Y, const float* gpost, int gate_idx, float w,
                                           const float* gpre, int shift_idx, int scale_idx, bf16* H, const float* modpost, const float* modpre, int nrows, int lane, int gw, int NGW) {
    asm volatile("" : "+v"(lane));
    const int rpw = (nrows + NGW - 1) / NGW;
    const int r0 = gw * rpw, r1 = min(nrows, r0 + rpw);
    f32x4 A[4], Bc[4], Sh[4];
#pragma unroll
    for (int j = 0; j < 4; ++j) { A[j] = (f32x4){0.f, 0.f, 0.f, 0.f}; Bc[j] = A[j]; Sh[j] = A[j]; }
    int cur = -1;
    for (int r = r0; r < r1; ++r) {
        const int mr = r < ML ? (r >> 11) : 8;
        if (mr != cur) { cur = mr; const float* mp = modpost + (size_t)mr * (NMOD * DM); const float* mq = modpre + (size_t)mr * (NMOD * DM);
#pragma unroll
            for (int j = 0; j < 4; ++j) { const int c = 4 * lane + 256 * j;
                if (Y) { const f32x4 g = *(const f32x4*)(gpost + c), gt = *(const f32x4*)(mp + gate_idx * DM + c); A[j] = g * gt * w; }
                if (H) { const f32x4 g = *(const f32x4*)(gpre + c), sc = *(const f32x4*)(mq + scale_idx * DM + c); Bc[j] = g * (sc + 1.0f); Sh[j] = *(const f32x4*)(mq + shift_idx * DM + c); } } }
        const float* xr = r < ML ? xin_lat + (size_t)r * DM : xin_ctx + (size_t)(r - ML) * DM;
        f32x4 xv[4];
#pragma unroll
        for (int j = 0; j < 4; ++j) xv[j] = *(const f32x4*)(xr + 4 * lane + 256 * j);
        if (Y) {
            f32x4 yv[4]; float ss = 0.f;
#pragma unroll
            for (int j = 0; j < 4; ++j) { const u32x2 wv = *(const u32x2*)(Y + (size_t)r * DM + 4 * lane + 256 * j);
                yv[j] = (f32x4){bf_lo(wv.x), bf_hi(wv.x), bf_lo(wv.y), bf_hi(wv.y)}; ss += (yv[j][0] * yv[j][0] + yv[j][1] * yv[j][1]) + (yv[j][2] * yv[j][2] + yv[j][3] * yv[j][3]); }
            const float rstd = __builtin_amdgcn_rsqf(wave_sum(ss) * (1.0f / DM) + RMS_EPS);
#pragma unroll
            for (int j = 0; j < 4; ++j) xv[j] += A[j] * (yv[j] * rstd);
            float* xo = r < ML ? xout_lat + (size_t)r * DM : xout_ctx + (size_t)(r - ML) * DM;
#pragma unroll
            for (int j = 0; j < 4; ++j) *(f32x4*)(xo + 4 * lane + 256 * j) = xv[j];
        }
        if (H) {
            float ss = 0.f;
#pragma unroll
            for (int j = 0; j < 4; ++j) ss += (xv[j][0] * xv[j][0] + xv[j][1] * xv[j][1]) + (xv[j][2] * xv[j][2] + xv[j][3] * xv[j][3]);
            const float rstd = __builtin_amdgcn_rsqf(wave_sum(ss) * (1.0f / DM) + RMS_EPS);
#pragma unroll
            for (int j = 0; j < 4; ++j) { const f32x4 h = xv[j] * rstd * Bc[j] + Sh[j]; u32x2 wv; wv.x = pg8::cvt_pk_bf16(h[0], h[1]); wv.y = pg8::cvt_pk_bf16(h[2], h[3]);
                *(u32x2*)(H + (size_t)r * DM + 4 * lane + 256 * j) = wv; }
        }
    }
}

__device__ __forceinline__ void unpack8(const v4u w, float (&f)[8]) { f[0] = bf_lo(w.x); f[1] = bf_hi(w.x); f[2] = bf_lo(w.y); f[3] = bf_hi(w.y); f[4] = bf_lo(w.z); f[5] = bf_hi(w.z); f[6] = bf_lo(w.w); f[7] = bf_hi(w.w); }
__device__ __forceinline__ void zero8(float (&f)[8]) {
#pragma unroll
    for (int i = 0; i < 8; ++i) f[i] = 0.f; }
__device__ __forceinline__ void conv_phase(const bf16* Bb, const bf16* CU, const float* cw, bf16* P, int nrows, int lane, int gw, int NGW) {
    asm volatile("" : "+v"(lane));
    const int rpw = (nrows + NGW - 1) / NGW;
    const int r0 = gw * rpw, r1 = min(nrows, r0 + rpw);
    if (r0 >= r1) return;
    float w0[2][8], w1[2][8], w2[2][8];
#pragma unroll
    for (int j = 0; j < 2; ++j)
#pragma unroll
        for (int i = 0; i < 8; ++i) { const int c = 512 * j + 8 * lane + i; w0[j][i] = cw[c]; w1[j][i] = cw[DM + c]; w2[j][i] = cw[2 * DM + c]; }
    float pv[2][8], cv[2][8], nv[2][8];
#pragma unroll
    for (int j = 0; j < 2; ++j) {
        if (r0 > 0) unpack8(*(const v4u*)(CU + (size_t)(r0 - 1) * DM + 512 * j + 8 * lane), pv[j]); else zero8(pv[j]);
        unpack8(*(const v4u*)(CU + (size_t)r0 * DM + 512 * j + 8 * lane), cv[j]);
    }
    for (int r = r0; r < r1; ++r) {
        const bool sstart = r < ML ? ((r & (SEQ - 1)) == 0) : ((r & (CTXL - 1)) == 0);
        const bool send = r < ML ? ((r & (SEQ - 1)) == SEQ - 1) : ((r & (CTXL - 1)) == CTXL - 1);
        const bool havenext = (r + 1) < MA;
#pragma unroll
        for (int j = 0; j < 2; ++j) {
            if (havenext) unpack8(*(const v4u*)(CU + (size_t)(r + 1) * DM + 512 * j + 8 * lane), nv[j]); else zero8(nv[j]);
            float bb[8]; unpack8(*(const v4u*)(Bb + (size_t)r * DM + 512 * j + 8 * lane), bb);
            float o[8];
#pragma unroll
            for (int i = 0; i < 8; ++i) { const float p = sstart ? 0.f : pv[j][i], nx = send ? 0.f : nv[j][i]; o[i] = bb[i] * (w0[j][i] * p + w1[j][i] * cv[j][i] + w2[j][i] * nx); }
            v4u w; w.x = pg8::cvt_pk_bf16(o[0], o[1]); w.y = pg8::cvt_pk_bf16(o[2], o[3]); w.z = pg8::cvt_pk_bf16(o[4], o[5]); w.w = pg8::cvt_pk_bf16(o[6], o[7]);
            *(v4u*)(P + (size_t)r * DM + 512 * j + 8 * lane) = w;
#pragma unroll
            for (int i = 0; i < 8; ++i) { pv[j][i] = cv[j][i]; cv[j][i] = nv[j][i]; }
        }
    }
}

constexpr int ATT_KST = 144, ATT_VST = 264, ATT_VOFF = 128 * ATT_KST, ATT_QOFF = 40960;
typedef unsigned long long u64;
__device__ __forceinline__ void attn_unit(LAS unsigned char* lds, const bf16* Q, const bf16* Kb, const bf16* Vt, bf16* O, const float* sink,
                                          int b, int hk, int nblk, bool latq, int tid) {
    asm volatile("" : "+v"(tid));
    const int lane = tid & 63, wave = __builtin_amdgcn_readfirstlane(tid >> 6);
    const int g = wave >> 1, wq = wave & 1, head = hk * 4 + g, r32 = lane & 31, hi = lane >> 5;
    const int qrow0 = (latq ? b * SEQ + nblk * 128 : ML + b * CTXL + nblk * 128) + wq * 64;
    const float sk = sink[head] * LOG2E;
    const bf16* vbase = Vt + ((size_t)(b * NKV + hk) * HD) * KEYS;
#pragma unroll 1
    for (int qt = 0; qt < 2; ++qt) {
        pg8::bf16x8 qf[4];
#pragma unroll
        for (int ks = 0; ks < 4; ++ks) qf[ks] = *(const pg8::bf16x8*)(Q + (size_t)(qrow0 + 32 * qt + r32) * DM + head * HD + 16 * ks + 8 * hi);
        f32x16 o[2];
#pragma unroll
        for (int dt = 0; dt < 2; ++dt)
#pragma unroll
            for (int i = 0; i < 16; ++i) o[dt][i] = 0.f;
        float mrun = sk, lrun = hi == 0 ? 1.f : 0.f;
        const int dlq = 4 * hi - (wq * 64 + 32 * qt + r32);
#pragma unroll 1
        for (int c = latq ? 0 : 3; c < 5; ++c) {
            const int kb = nblk - 1 + c;
            if (c < 3 && (kb < 0 || kb >= SEQ / 128)) continue;
            const int krow0 = c < 3 ? b * SEQ + kb * 128 : ML + b * CTXL + (c - 3) * 128;
            const int vkey0 = c < 3 ? kb * 128 : SEQ + (c - 3) * 128;
            __syncthreads();
            { const int row = tid >> 2, pc = tid & 3; const v4u* src = (const v4u*)(Kb + (size_t)(krow0 + row) * 256 + hk * HD + pc * 16);
              const v4u k0 = src[0], k1 = src[1]; LAS v4u* dst = (LAS v4u*)(lds + row * ATT_KST + pc * 32); dst[0] = k0; dst[1] = k1; }
            { const int d = tid >> 3, pc = tid & 7; const v4u* src = (const v4u*)(vbase + (size_t)d * KEYS + vkey0 + pc * 16);
              const v4u v0 = src[0], v1 = src[1]; LAS u64* dst = (LAS u64*)(lds + ATT_VOFF + d * ATT_VST + pc * 32);
              dst[0] = ((u64)v0.y << 32) | v0.x; dst[1] = ((u64)v0.w << 32) | v0.z; dst[2] = ((u64)v1.y << 32) | v1.x; dst[3] = ((u64)v1.w << 32) | v1.z; }
            __syncthreads();
            const int sgn = (c == 0) ? 1 : -1;
            const int dls = sgn * dlq;
#pragma unroll
            for (int kh = 0; kh < 2; ++kh) {
                f32x16 s[2];
#pragma unroll
                for (int k2 = 0; k2 < 2; ++k2) {
                    const int kt = 2 * kh + k2;
#pragma unroll
                    for (int i = 0; i < 16; ++i) s[k2][i] = 0.f;
#pragma unroll
                    for (int ks = 0; ks < 4; ++ks) { const pg8::bf16x8 kf = *(const LAS pg8::bf16x8*)(lds + (32 * kt + r32) * ATT_KST + (16 * ks + 8 * hi) * 2);
                        s[k2] = __builtin_amdgcn_mfma_f32_32x32x16_bf16(kf, qf[ks], s[k2], 0, 0, 0); }
                }
                if (c == 0 || c == 2) {
#pragma unroll
                    for (int k2 = 0; k2 < 2; ++k2)
#pragma unroll
                        for (int i = 0; i < 16; ++i) { const int cj = 32 * (2 * kh + k2) + (i & 3) + 8 * (i >> 2); const int t = min(dls + sgn * cj, 0); s[k2][i] = fmaf((float)t, 1e30f, s[k2][i]); }
                }
                float mx = s[0][0];
#pragma unroll
                for (int k2 = 0; k2 < 2; ++k2)
#pragma unroll
                    for (int i = 0; i < 16; ++i) mx = fmaxf(mx, s[k2][i]);
                mx = fmaxf(mx, __shfl_xor(mx, 32));
                const float mnew = fmaxf(mrun, mx), alpha = __builtin_amdgcn_exp2f(mrun - mnew);
                mrun = mnew;
                float ls = 0.f;
#pragma unroll
                for (int k2 = 0; k2 < 2; ++k2)
#pragma unroll
                    for (int i = 0; i < 16; ++i) { s[k2][i] = __builtin_amdgcn_exp2f(s[k2][i] - mnew); ls += s[k2][i]; }
                lrun = lrun * alpha + ls;
#pragma unroll
                for (int dt = 0; dt < 2; ++dt)
#pragma unroll
                    for (int i = 0; i < 16; ++i) o[dt][i] *= alpha;
#pragma unroll
                for (int k2 = 0; k2 < 2; ++k2)
#pragma unroll
                    for (int s2 = 0; s2 < 2; ++s2) {
                        const int kt = 2 * kh + k2;
                        u32x4 pw; pw.x = pg8::cvt_pk_bf16(s[k2][8 * s2 + 0], s[k2][8 * s2 + 1]); pw.y = pg8::cvt_pk_bf16(s[k2][8 * s2 + 2], s[k2][8 * s2 + 3]);
                        pw.z = pg8::cvt_pk_bf16(s[k2][8 * s2 + 4], s[k2][8 * s2 + 5]); pw.w = pg8::cvt_pk_bf16(s[k2][8 * s2 + 6], s[k2][8 * s2 + 7]);
                        const pg8::bf16x8 pf = __builtin_bit_cast(pg8::bf16x8, pw);
#pragma unroll
                        for (int dt = 0; dt < 2; ++dt) {
                            const LAS unsigned char* vp = lds + ATT_VOFF + (32 * dt + r32) * ATT_VST + (32 * kt + 16 * s2 + 4 * hi) * 2;
                            const u64 a0 = *(const LAS u64*)vp, a1 = *(const LAS u64*)(vp + 16);
                            u32x4 vw; vw.x = (unsigned)a0; vw.y = (unsigned)(a0 >> 32); vw.z = (unsigned)a1; vw.w = (unsigned)(a1 >> 32);
                            o[dt] = __builtin_amdgcn_mfma_f32_32x32x16_bf16(__builtin_bit_cast(pg8::bf16x8, vw), pf, o[dt], 0, 0, 0);
                        }
                    }
                __builtin_amdgcn_sched_barrier(0);
            }
        }
        const float lt = lrun + __shfl_xor(lrun, 32), inv = 1.0f / lt;
        bf16* orow = O + (size_t)(qrow0 + 32 * qt + r32) * DM + head * HD;
#pragma unroll
        for (int dt = 0; dt < 2; ++dt)
#pragma unroll
            for (int q4 = 0; q4 < 4; ++q4) { u32x2 w; w.x = pg8::cvt_pk_bf16(o[dt][4 * q4 + 0] * inv, o[dt][4 * q4 + 1] * inv); w.y = pg8::cvt_pk_bf16(o[dt][4 * q4 + 2] * inv, o[dt][4 * q4 + 3] * inv);
                *(u32x2*)(orow + 32 * dt + 8 * q4 + 4 * hi) = w; }
    }
}

constexpr int N_PHASES = 2 + 10 * DEPTH;
#ifndef MK_EN
#define MK_EN 0xff
#endif
#define EN(x) (((MK_EN) >> (x)) & 1)
__global__ void __launch_bounds__(NWAVES * 64, 2) mk_fwd(Args args) {
    extern __shared__ __attribute__((aligned(16))) unsigned char lds_raw[];
    LAS unsigned char* lds = (LAS unsigned char*)lds_raw;
    volatile LAS unsigned* MISC = (volatile LAS unsigned*)(lds + MISC_OFF);
    const int tid = threadIdx.x, lane = tid & 63, wave = __builtin_amdgcn_readfirstlane(tid >> 6);
    const int G = gridDim.x; const int bx = blockIdx.x; const int vcu = (G % 8 == 0) ? (bx % 8) * (G / 8) + bx / 8 : bx;
    const int gw = vcu * NWAVES + wave, NGW = G * NWAVES;
    unsigned char* ws = args.ws;
    for (int u = tid; u < (LDS_BYTES - LDSCTL_OFF) / 4; u += NWAVES * 64) ((LAS unsigned*)(lds + LDSCTL_OFF))[u] = 0u;
    __syncthreads();
    XcdBarrier bar; bar.bar = (unsigned*)(ws + WS_CTL) + CW_BAR; bar.x = 0; bar.st = nullptr;
    if (args.use_bar) bar = xcd_barrier_post((unsigned*)(ws + WS_CTL) + CW_BAR, MISC + 8);

    bf16* const Hb = (bf16*)(ws + WS_H); bf16* const Yb = (bf16*)(ws + WS_Y); bf16* const ACT = (bf16*)(ws + WS_ACT);
    bf16* const MQ = (bf16*)(ws + WS_MIXQ); bf16* const MK = (bf16*)(ws + WS_MIXK); bf16* const MV = (bf16*)(ws + WS_MIXV); bf16* const MA_ = (bf16*)(ws + WS_MIXA);
    float* const X = (float*)(ws + WS_X);
    const float* const MOD = (const float*)(ws + WS_MOD);
    const float* const cosT = (const float*)(ws + WS_ROPE); const float* const sinT = cosT + 64 * 16;

    if (args.ph_lo == 0) {
        if (EN(0)) prologue_phase(args, lds, tid, lane, wave, vcu, G);
        if (args.ph_hi > 1) cg::this_grid().sync();
    }
    for (int ph = max(args.ph_lo, 1); ph < args.ph_hi; ++ph) {
        {
            const int l = ph == 1 ? -1 : (ph - 2) / 10, st = ph == 1 ? 9 : (ph - 2) % 10;
            const bool last = (l == DEPTH - 1), attn = (l & 1) == 1; const int j = l >> 1;
            const int Mpost = last ? ML : MA;
            const float* gl = args.in[6] + (long)l * 6 * DM;
            const float* modl = MOD + (long)l * 9 * (NMOD * DM);
            if (st == 0 || st == 7 || st == 1 || st == 8 || st == 5 || st == 3) {
                const bool gu = (st == 0 || st == 7), dn = (st == 1 || st == 8);
                const int f = st >= 7 ? 1 : 0;
                const int M = (st <= 3) ? MA : Mpost;
                const int N = gu ? 2 * DFF : (st == 3 ? (attn ? NQKV : 3 * DM) : DM);
                const int K = dn ? DFF : DM;
                const bf16* A = gu || st == 3 ? Hb : (dn ? ACT : MA_);
                const bf16* Bt = gu ? (const bf16*)(ws + WS_WGU) + (size_t)(l * 2 + f) * 2 * DFF * DM
                               : dn ? (const bf16*)(ws + WS_WDN) + (size_t)(l * 2 + f) * DM * DFF
                               : st == 3 ? (attn ? (const bf16*)(ws + WS_WQKV) + (size_t)j * NQKV * DM : (const bf16*)(ws + WS_WCI) + (size_t)j * 3 * DM * DM)
                               : (attn ? (const bf16*)(ws + WS_WO) + (size_t)j * DM * DM : (const bf16*)(ws + WS_WCO) + (size_t)j * DM * DM);
                const int mode = gu ? 1 : (st == 3 ? (attn ? 3 : 2) : 0);
                pg8::Gemm g{A, Bt, M, N, K}; pg8::StaticOrder S; S.init(M, N, G, bx);
                pg8::EpiAll E{mode, mode != 3, gu ? ACT : (st == 3 ? MQ : Yb), MK, MV, gu ? DFF : DM, cosT, sinT};
                if (EN(2)) pg8::gemm_phase<pg8::EpiAll, pg8::StaticOrder, PG8_ALIGN, PG8_SP2>(lds, g, S, E);
            } else if (st == 2 || st == 6 || st == 9) {
                const bool first = (l == 0 && st == 2), init = (l < 0);
                const float* xin_lat = (first || init) ? args.in[0] : X; const float* xin_ctx = (first || init) ? args.in[2] : X + (size_t)ML * DM;
                float* xout_lat = (last && st == 9) ? args.out : X; float* xout_ctx = X + (size_t)ML * DM;
                const bf16* Yp = init ? nullptr : Yb;
                const float* gpost = gl + (st == 2 ? 1 : (st == 6 ? 3 : 5)) * DM; const int gate_idx = st == 2 ? 2 : (st == 6 ? 5 : 8); const float w = st == 6 ? 1.0f : 0.5f;
                const float* gpre = st == 9 ? gl + 6 * DM : gl + st * DM;
                const float* gpre2 = st == 6 ? gl + 4 * DM : gpre;
                const int shift_idx = st == 2 ? 3 : (st == 6 ? 6 : 0);
                bf16* Hp = (last && st == 9) ? nullptr : Hb;
                const float* modpre = st == 9 ? modl + (size_t)9 * (NMOD * DM) : modl;
                const int nrows = (st == 2 || init) ? MA : Mpost;
                if (EN(1)) norm_phase(xin_lat, xin_ctx, xout_lat, xout_ctx, Yp, gpost, gate_idx, w, gpre2, shift_idx, shift_idx + 1, Hp, modl, modpre, nrows, lane, gw, NGW);
            } else {
                if (attn) {
                    const int nlat = NBATCH * NKV * (SEQ / 128), nctx = last ? 0 : NBATCH * NKV * (CTXL / 128);
                    for (int u = vcu; u < nlat + nctx; u += G) {
                        const bool latq = u < nlat; const int v = latq ? u : u - nlat; const int nb = latq ? SEQ / 128 : CTXL / 128;
                        const int nblk = v % nb, hk = (v / nb) % NKV, b = v / (nb * NKV);
                        if (EN(6)) attn_unit(lds, MQ, MK, MV, MA_, args.in[14] + (size_t)j * NHEAD, b, hk, nblk, latq, tid);
                    }
                } else {
                    if (EN(7)) conv_phase(MQ, MK, args.in[10] + (size_t)j * 3 * DM, MA_, MA, lane, gw, NGW);
                }
            }
        }
        if (ph + 1 < args.ph_hi) xcd_barrier(bar);
    }
}

extern "C" void kernel_launch(void* const* d_in, const int* in_sizes, int n_in, void* d_out, int out_size, void* d_ws, size_t ws_size, hipStream_t stream) {
    static int grid = 0;
    if (grid == 0) {
        if (n_in != 15 || in_sizes[0] != ML * DM || out_size != ML * DM || ws_size < WS_END) { fprintf(stderr, "kernel_launch: unexpected shapes (n_in %d, in0 %d, out %d, ws %zu)\n", n_in, n_in > 0 ? in_sizes[0] : -1, out_size, ws_size); grid = -1; return; }
        int dev = 0, cus = 0, per_cu = 0;
        if (hipGetDevice(&dev) != hipSuccess || hipDeviceGetAttribute(&cus, hipDeviceAttributeMultiprocessorCount, dev) != hipSuccess) { grid = -1; return; }
        if (hipFuncSetAttribute((const void*)mk_fwd, hipFuncAttributeMaxDynamicSharedMemorySize, LDS_BYTES) != hipSuccess) { fprintf(stderr, "kernel_launch: hipFuncSetAttribute failed\n"); grid = -1; return; }
        if (hipOccupancyMaxActiveBlocksPerMultiprocessor(&per_cu, (const void*)mk_fwd, NWAVES * 64, LDS_BYTES) != hipSuccess || per_cu < 1) { fprintf(stderr, "kernel_launch: occupancy query says %d\n", per_cu); per_cu = 1; }
        (void)hipGetLastError();
        grid = cus;
    }
    if (grid < 0) return;
    (void)hipMemsetAsync((char*)d_ws + WS_CTL, 0, CTL_ZERO_BYTES, stream);
    Args a{};
    for (int i = 0; i < 15; ++i) a.in[i] = (const float*)d_in[i];
    a.out = (float*)d_out; a.ws = (unsigned char*)d_ws;
#ifndef MK_MULTI
#define MK_MULTI 0
#endif
#if MK_MULTI
    for (int p = 0; p < N_PHASES; ++p) { a.ph_lo = p; a.ph_hi = p + 1; a.use_bar = 0; hipLaunchKernelGGL(mk_fwd, dim3(grid), dim3(NWAVES * 64), LDS_BYTES, stream, a); }
#else
    a.ph_lo = 0; a.ph_hi = N_PHASES; a.use_bar = 1;
    void* kargs[] = {&a};
    hipError_t e = hipLaunchCooperativeKernel((const void*)mk_fwd, dim3(grid), dim3(NWAVES * 64), kargs, LDS_BYTES, stream);
    if (e != hipSuccess) fprintf(stderr, "kernel_launch: cooperative launch failed: %s (grid %d)\n", hipGetErrorString(e), grid);
#endif
}
```
